# Optimizing an MI355X kernel written in HIP

```python
import jax, jax.numpy as jnp
from jax import lax
import numpy as np

D_MODEL = 4096
BATCH = 8
SEQ = 2048
DEPTH = 2

HEAD_DIM = 128
D_LRU = D_MODEL // 4
LRU_BLOCKS = D_LRU // HEAD_DIM
LRU_BLOCK = D_LRU // LRU_BLOCKS
CONV_WIDTH = 4
LRU_C = 8.0
N_FOX = D_MODEL // 4 // HEAD_DIM
D_FOX = N_FOX * HEAD_DIM
D_DIL = D_MODEL - D_LRU - D_FOX
N_DIL = D_DIL // HEAD_DIM
D_MIX = D_LRU + D_FOX + D_DIL
D_IN = 2 * D_LRU + 3 * D_FOX + N_FOX + 3 * D_DIL
D_FF = 11008
ROPE_THETA = 500000.0
ROPE_DIM = HEAD_DIM // 4
DILATED_PATTERNS = ((128, 1), (512, 4), (2048, 16))
Q_BLOCK = 128
EPS = 1e-6

kernel_name = "hymba_style_lru_fox_dilated_macaron"


def rmsnorm(x, g):
    x32 = x.astype(jnp.float32)
    y = x32 * lax.rsqrt(jnp.mean(x32 * x32, axis=-1, keepdims=True) + EPS)
    return (y * g.astype(jnp.float32)).astype(x.dtype)


def swiglu(x, w_in, w_out):
    gu = x @ w_in
    gate, up = gu[..., :D_FF], gu[..., D_FF:]
    return (jax.nn.silu(gate) * up) @ w_out


def rope_tables(seq):
    inv = 1.0 / (ROPE_THETA ** (jnp.arange(0, ROPE_DIM, 2, dtype=jnp.float32) / ROPE_DIM))
    ang = jnp.arange(seq, dtype=jnp.float32)[:, None] * inv[None, :]
    return jnp.cos(ang), jnp.sin(ang)


def apply_partial_rope(x, cos, sin):
    half = ROPE_DIM // 2
    x1 = x[..., :half].astype(jnp.float32)
    x2 = x[..., half:ROPE_DIM].astype(jnp.float32)
    c = cos[None, :, None, :]
    s = sin[None, :, None, :]
    rot = jnp.concatenate([x1 * c - x2 * s, x2 * c + x1 * s], axis=-1).astype(x.dtype)
    return jnp.concatenate([rot, x[..., ROPE_DIM:]], axis=-1)


def causal_depthwise_conv(x, w, b):
    S = x.shape[1]
    xp = jnp.pad(x, ((0, 0), (CONV_WIDTH - 1, 0), (0, 0)))
    y = b
    for j in range(CONV_WIDTH):
        y = y + xp[:, j:j + S] * w[j]
    return y


def rg_lru(x, w_a, b_a, w_x, b_x, lam):
    B, S, C = x.shape
    xb = x.reshape(B, S, LRU_BLOCKS, LRU_BLOCK)
    r = jax.nn.sigmoid(jnp.einsum('bsgi,gij->bsgj', xb, w_a).reshape(B, S, C) + b_a)
    i = jax.nn.sigmoid(jnp.einsum('bsgi,gij->bsgj', xb, w_x).reshape(B, S, C) + b_x)
    log_a = -LRU_C * r.astype(jnp.float32) * jax.nn.softplus(-lam.astype(jnp.float32))
    a = jnp.exp(log_a)
    u = jnp.sqrt(-jnp.expm1(2.0 * log_a)) * (i * x).astype(jnp.float32)

    def combine(c1, c2):
        a1, b1 = c1
        a2, b2 = c2
        return a1 * a2, a2 * b1 + b2

    _, h = lax.associative_scan(combine, (a, u), axis=1)
    return h.astype(x.dtype)


def forgetting_attention(q, k, v, log_f):
    B, S, H, hd = q.shape
    nb = S // Q_BLOCK
    cum = jnp.cumsum(log_f, axis=1).transpose(0, 2, 1)
    qb = q.reshape(B, nb, Q_BLOCK, H, hd).transpose(1, 0, 2, 3, 4)
    cb = cum.reshape(B, H, nb, Q_BLOCK).transpose(2, 0, 1, 3)
    k_pos = jnp.arange(S)
    scale = hd ** -0.5

    def one_block(args):
        blk, q_i, c_i = args
        s = jnp.einsum('bqhe,bkhe->bhqk', q_i, k).astype(jnp.float32) * scale
        s = s + c_i[..., None] - cum[:, :, None, :]
        q_pos = blk * Q_BLOCK + jnp.arange(Q_BLOCK)
        s = jnp.where((k_pos[None, :] <= q_pos[:, None])[None, None], s, -jnp.inf)
        p = jax.nn.softmax(s, axis=-1)
        return jnp.einsum('bhqk,bkhe->bqhe', p.astype(v.dtype), v)

    out = lax.map(one_block, (jnp.arange(nb), qb, cb))
    return out.transpose(1, 0, 2, 3, 4).reshape(B, S, H, hd)


def dilated_window_attention(q, k, v, window, dilation):
    B, S, H, hd = q.shape
    steps = window // dilation
    L = S // dilation
    nb = -(-L // Q_BLOCK)
    Lp = nb * Q_BLOCK

    def to_strided(t):
        t = t.reshape(B, L, dilation, H, hd).transpose(0, 2, 1, 3, 4)
        return jnp.pad(t, ((0, 0), (0, 0), (0, Lp - L), (0, 0), (0, 0)))

    def key_band(t):
        t = jnp.pad(to_strided(t), ((0, 0), (0, 0), (Q_BLOCK, 0), (0, 0), (0, 0)))
        t = t.reshape(B, dilation, nb + 1, Q_BLOCK, H, hd)
        return jnp.concatenate([t[:, :, :-1], t[:, :, 1:]], axis=3)

    qs = to_strided(q).reshape(B, dilation, nb, Q_BLOCK, H, hd)
    kw = key_band(k)
    vw = key_band(v)
    s = jnp.einsum('brnqhe,brnkhe->brnhqk', qs, kw).astype(jnp.float32) * (hd ** -0.5)
    blk = jnp.arange(nb)[:, None, None]
    qpos = jnp.arange(Q_BLOCK)[None, :, None]
    kpos = jnp.arange(2 * Q_BLOCK)[None, None, :] - Q_BLOCK
    rel = qpos - kpos
    valid = (rel >= 0) & (rel <= steps) & (blk * Q_BLOCK + kpos >= 0)
    s = jnp.where(valid[None, None, :, None], s, -jnp.inf)
    m = jnp.max(s, axis=-1, keepdims=True)
    e = jnp.exp(s - m)
    den = jnp.sum(e, axis=-1, keepdims=True)
    p = e / den
    lse = (m + jnp.log(den))[..., 0]
    o = jnp.einsum('brnhqk,brnkhe->brnqhe', p.astype(v.dtype), vw)
    o = o.reshape(B, dilation, Lp, H, hd)[:, :, :L].transpose(0, 2, 1, 3, 4).reshape(B, S, H, hd)
    lse = lse.transpose(0, 1, 2, 4, 3).reshape(B, dilation, Lp, H)[:, :, :L]
    lse = lse.transpose(0, 2, 1, 3).reshape(B, S, H)
    return o, lse


def dilated_mixture(q, k, v):
    outs, lses = [], []
    for window, dilation in DILATED_PATTERNS:
        o, l = dilated_window_attention(q, k, v, window, dilation)
        outs.append(o)
        lses.append(l)
    w = jax.nn.softmax(jnp.stack(lses, axis=0), axis=0)
    out = sum(w[i][..., None] * outs[i].astype(jnp.float32) for i in range(len(outs)))
    return out.astype(q.dtype)


def hybrid_mixer(h, w_in, conv_w, conv_b, lru_w_a, lru_b_a, lru_w_x, lru_b_x, lru_lam,
                 fox_b_f, out_norm_lru, out_norm_fox, out_norm_dil, w_out, cos, sin):
    B, S, _ = h.shape
    proj = h @ w_in
    sizes = (D_LRU, D_LRU, D_FOX, D_FOX, D_FOX, N_FOX, D_DIL, D_DIL, D_DIL)
    points = np.cumsum(sizes)[:-1].tolist()
    xa, ga, qf, kf, vf, ff, qd, kd, vd = jnp.split(proj, points, axis=-1)

    xa = causal_depthwise_conv(xa, conv_w, conv_b)
    y_a = rg_lru(xa, lru_w_a, lru_b_a, lru_w_x, lru_b_x, lru_lam) * jax.nn.gelu(ga)

    log_f = jax.nn.log_sigmoid(ff.astype(jnp.float32) + fox_b_f.astype(jnp.float32))
    hd4 = lambda t, n: t.reshape(B, S, n, HEAD_DIM)
    y_b = forgetting_attention(hd4(qf, N_FOX), hd4(kf, N_FOX), hd4(vf, N_FOX), log_f).reshape(B, S, D_FOX)

    qd = apply_partial_rope(hd4(qd, N_DIL), cos, sin)
    kd = apply_partial_rope(hd4(kd, N_DIL), cos, sin)
    y_c = dilated_mixture(qd, kd, hd4(vd, N_DIL)).reshape(B, S, D_DIL)

    y = jnp.concatenate([rmsnorm(y_a, out_norm_lru), rmsnorm(y_b, out_norm_fox), rmsnorm(y_c, out_norm_dil)], axis=-1)
    return y @ w_out


def setup_inputs(seed: int = 0) -> dict:
    key = jax.random.key(seed)
    ks = jax.random.split(key, 24)
    L = DEPTH

    def nrm(k, shape, fan_in):
        return jax.random.normal(k, shape, jnp.float32) * (fan_in ** -0.5)

    def gain(k, shape):
        return 1.0 + 0.05 * jax.random.normal(k, shape, jnp.float32)

    def bias(k, shape):
        return 0.01 * jax.random.normal(k, shape, jnp.float32)

    u = jax.random.uniform(ks[12], (L, D_LRU), jnp.float32, minval=0.9, maxval=0.999)
    s = u ** (1.0 / LRU_C)
    lru_lam = jnp.log(s) - jnp.log1p(-s)
    return {
        "x": jax.random.normal(ks[0], (BATCH, SEQ, D_MODEL), jnp.float32),
        "ffn1_norm": gain(ks[1], (L, D_MODEL)),
        "ffn1_w_in": nrm(ks[2], (L, D_MODEL, 2 * D_FF), D_MODEL),
        "ffn1_w_out": nrm(ks[3], (L, D_FF, D_MODEL), D_FF),
        "mix_norm": gain(ks[4], (L, D_MODEL)),
        "mix_w_in": nrm(ks[5], (L, D_MODEL, D_IN), D_MODEL),
        "conv_w": nrm(ks[6], (L, CONV_WIDTH, D_LRU), CONV_WIDTH),
        "conv_b": bias(ks[7], (L, D_LRU)),
        "lru_w_a": nrm(ks[8], (L, LRU_BLOCKS, LRU_BLOCK, LRU_BLOCK), LRU_BLOCK),
        "lru_b_a": bias(ks[9], (L, D_LRU)),
        "lru_w_x": nrm(ks[10], (L, LRU_BLOCKS, LRU_BLOCK, LRU_BLOCK), LRU_BLOCK),
        "lru_b_x": bias(ks[11], (L, D_LRU)),
        "lru_lam": lru_lam,
        "fox_b_f": 3.0 + 0.1 * jax.random.normal(ks[13], (L, N_FOX), jnp.float32),
        "out_norm_lru": gain(ks[14], (L, D_LRU)),
        "out_norm_fox": gain(ks[15], (L, D_FOX)),
        "out_norm_dil": gain(ks[16], (L, D_DIL)),
        "mix_w_out": nrm(ks[17], (L, D_MIX, D_MODEL), D_MIX),
        "ffn2_norm": gain(ks[18], (L, D_MODEL)),
        "ffn2_w_in": nrm(ks[19], (L, D_MODEL, 2 * D_FF), D_MODEL),
        "ffn2_w_out": nrm(ks[20], (L, D_FF, D_MODEL), D_FF),
        "final_norm": gain(ks[21], (D_MODEL,)),
    }


def reference(x, ffn1_norm, ffn1_w_in, ffn1_w_out, mix_norm, mix_w_in, conv_w, conv_b,
              lru_w_a, lru_b_a, lru_w_x, lru_b_x, lru_lam, fox_b_f,
              out_norm_lru, out_norm_fox, out_norm_dil, mix_w_out,
              ffn2_norm, ffn2_w_in, ffn2_w_out, final_norm):
    cos, sin = rope_tables(x.shape[1])
    h = x
    for l in range(DEPTH):
        h = h + 0.5 * swiglu(rmsnorm(h, ffn1_norm[l]), ffn1_w_in[l], ffn1_w_out[l])
        h = h + hybrid_mixer(rmsnorm(h, mix_norm[l]), mix_w_in[l], conv_w[l], conv_b[l],
                             lru_w_a[l], lru_b_a[l], lru_w_x[l], lru_b_x[l], lru_lam[l], fox_b_f[l],
                             out_norm_lru[l], out_norm_fox[l], out_norm_dil[l], mix_w_out[l], cos, sin)
        h = h + 0.5 * swiglu(rmsnorm(h, ffn2_norm[l]), ffn2_w_in[l], ffn2_w_out[l])
    return rmsnorm(h, final_norm)
```

```cpp
#include <hip/hip_runtime.h>
#include <cstdio>
#include <cstdint>
namespace pg8 {
#define PG8_LAS __attribute__((address_space(3)))
typedef unsigned short bf16_t;
typedef short bf16x8 __attribute__((ext_vector_type(8)));
typedef float f32x4 __attribute__((ext_vector_type(4)));
typedef unsigned u32x4 __attribute__((ext_vector_type(4)));
constexpr int BM = 256, BK = 64, HALF = 128, HTB = HALF * BK * 2  , STAGE_BYTES = 8 * HTB, NXCD = 8, WGM = 8;

__host__ __device__ __forceinline__ int lds_byte(int r, int c) { const int st = (r >> 4) * 2 + (c >> 5), rr = r & 15, cc = c & 31, ob = rr * 64 + cc * 2; return st * 1024 + (ob ^ (((ob >> 9) & 1) << 5)); }
__host__ __device__ __forceinline__ void stage_rc(int b, int& R, int& C) { const int st = b / 1024, sb = b % 1024, swz = sb ^ (((sb >> 9) & 1) << 5); R = (st >> 1) * 16 + swz / 64; C = (st & 1) * 32 + (swz % 64) / 2; }
__host__ __device__ __forceinline__ int perm32(int rho) { const int n = rho >> 4, i = rho & 15; return 8 * (i >> 2) + 4 * n + (i & 3); }

struct Unit { int pm, pn; };
struct Gemm { const bf16_t* A; const bf16_t* Bt; int M, N, K; };

struct StaticOrder {
    int nM, nN, nwg, G, c;
    __host__ __device__ void init(int M, int N, int G_, int c_) { nM = M / BM; nN = N / BM; nwg = nM * nN; G = G_; c = c_; }
    __host__ __device__ bool next(int i, Unit& u) const {
        const long L = (long)i * G + c; if (L >= nwg) return false;
        int wgid = (int)L; { const int q = nwg / NXCD, r = nwg % NXCD, xcd = wgid % NXCD, off = wgid / NXCD; wgid = (xcd < r ? xcd * (q + 1) : r * (q + 1) + (xcd - r) * q) + off; }
        const int nig = WGM * nN, gid = wgid / nig, fm = gid * WGM, gsz = (nM - fm) < WGM ? (nM - fm) : WGM;
        u.pm = fm + ((wgid % nig) % gsz); u.pn = (wgid % nig) / gsz; return true;
    }
    __device__ __forceinline__ void a_ready(const Unit&) const {}
    __device__ __forceinline__ void done(const Unit&) const {}
};

__device__ __forceinline__ unsigned cvt_pk_bf16(float lo, float hi) { unsigned r; asm volatile("v_cvt_pk_bf16_f32 %0, %1, %2" : "=v"(r) : "v"(lo), "v"(hi)); return r; }
typedef float f32x2 __attribute__((ext_vector_type(2)));
struct EpiSwiglu {
    static constexpr bool PERM = true, AFTER_DRAIN = false;
    bf16_t* O; int ldc;
    __device__ __forceinline__ void operator()(const f32x4 (&acc)[2][2][4][2], const Unit& u, int wr, int wc, int fr, int fq) const {
        const int row0 = u.pm * BM + wr * 64 + fr, col0 = u.pn * HALF + wc * 32 + 8 * fq;
#pragma unroll
        for (int ai = 0; ai < 2; ++ai)
#pragma unroll
            for (int m = 0; m < 4; ++m) { bf16_t* rowp = O + (size_t)(row0 + ai * HALF + m * 16) * ldc + col0;
                float r[8];
#pragma unroll
                for (int n = 0; n < 2; ++n)
#pragma unroll
                    for (int j = 0; j < 4; ++j) { const float g = acc[ai][0][m][n][j], up = acc[ai][1][m][n][j];
                        r[n * 4 + j] = g * __builtin_amdgcn_rcpf(1.0f + __expf(-g)) * up; }
                u32x4 w; w.x = cvt_pk_bf16(r[0], r[1]); w.y = cvt_pk_bf16(r[2], r[3]); w.z = cvt_pk_bf16(r[4], r[5]); w.w = cvt_pk_bf16(r[6], r[7]);
                *(u32x4*)rowp = w; }
    }
};
struct EpiResid {
    static constexpr bool PERM = false, AFTER_DRAIN = false;
    const float* base; float* out; int ldc; float s;
    __device__ __forceinline__ void operator()(const f32x4 (&acc)[2][2][4][2], const Unit& u, int wr, int wc, int fr, int fq) const {
        const int row0 = u.pm * BM + wr * 64 + fr, col0 = u.pn * BM + wc * 32 + 4 * fq;
#pragma unroll
        for (int ai = 0; ai < 2; ++ai)
#pragma unroll
            for (int m = 0; m < 4; ++m) { const size_t off = (size_t)(row0 + ai * HALF + m * 16) * ldc + col0;
#pragma unroll
                for (int bj = 0; bj < 2; ++bj)
#pragma unroll
                    for (int n = 0; n < 2; ++n) { const f32x4 b = *(const f32x4*)(base + off + bj * HALF + n * 16); *(f32x4*)(out + off + bj * HALF + n * 16) = b + acc[ai][bj][m][n] * s; }
                asm volatile("" ::: "memory"); }
    }
};
struct EpiProj {
    static constexpr bool PERM = true, AFTER_DRAIN = false;
    bf16_t* O; int ldc; const float* rope_cos; const float* rope_sin; int rope_lo, rope_hi;
    __device__ __forceinline__ void operator()(const f32x4 (&acc)[2][2][4][2], const Unit& u, int wr, int wc, int fr, int fq) const {
        const int row0 = u.pm * BM + wr * 64 + fr, col0 = u.pn * BM + wc * 32 + 8 * fq;
        const bool do_rope = (u.pn >= rope_lo) && (u.pn < rope_hi) && (wc == 0);
#pragma unroll
        for (int ai = 0; ai < 2; ++ai)
#pragma unroll
            for (int m = 0; m < 4; ++m) { const int row = row0 + ai * HALF + m * 16; bf16_t* rowp = O + (size_t)row * ldc + col0;
                f32x4 c0 = {1.f, 1.f, 1.f, 1.f}, c1 = c0, s0 = {0.f, 0.f, 0.f, 0.f}, s1 = s0;
                if (do_rope) { const int pos = row & 2047, i0 = (fq & 1) * 8;
                    c0 = *(const f32x4*)(rope_cos + pos * 16 + i0); c1 = *(const f32x4*)(rope_cos + pos * 16 + i0 + 4);
                    s0 = *(const f32x4*)(rope_sin + pos * 16 + i0); s1 = *(const f32x4*)(rope_sin + pos * 16 + i0 + 4);
                    if (fq < 2) { s0 = -s0; s1 = -s1; } }
#pragma unroll
                for (int bj = 0; bj < 2; ++bj) { f32x4 v0 = acc[ai][bj][m][0], v1 = acc[ai][bj][m][1];
                    if (do_rope) { f32x4 p0, p1;
#pragma unroll
                        for (int j = 0; j < 4; ++j) { p0[j] = __shfl_xor(v0[j], 32); p1[j] = __shfl_xor(v1[j], 32); }
                        v0 = v0 * c0 + p0 * s0; v1 = v1 * c1 + p1 * s1; }
                    u32x4 w; w.x = cvt_pk_bf16(v0[0], v0[1]); w.y = cvt_pk_bf16(v0[2], v0[3]); w.z = cvt_pk_bf16(v1[0], v1[1]); w.w = cvt_pk_bf16(v1[2], v1[3]);
                    *(u32x4*)(rowp + bj * HALF) = w; } }
    }
};

template <class Epi, class Sched, bool ALIGN_EPI = false, bool SP2 = false>
__device__ __forceinline__ void gemm_phase(PG8_LAS unsigned char* lds, const Gemm g, const Sched& S, const Epi& E) {
    int tid_ = threadIdx.x; asm volatile("" : "+v"(tid_));
    const int tid = tid_, wid = __builtin_amdgcn_readfirstlane(tid >> 6), lane = tid & 63, wr = wid >> 2, wc = wid & 3, fr = lane & 15, fq = lane >> 4;
    const int K = g.K, nt = K / BK;
    unsigned voffA[2], voffB[2];
#pragma unroll
    for (int i = 0; i < 2; ++i) { int R, C; stage_rc(tid * 16 + i * 8192, R, C); const int Rb = Epi::PERM ? ((R & ~31) + perm32(R & 31)) : R;
        voffA[i] = (unsigned)(R * K + C) * 2u; voffB[i] = (unsigned)(Rb * K + C) * 2u; }
    const size_t kstep = (size_t)(BK * 2);
    const size_t hstep = (size_t)HALF * K * 2;
    const size_t tstep = 2 * hstep;
    const unsigned ldsw = (unsigned)wid * 1024u;
    const int aoff = lds_byte(wr * 64 + fr, fq * 8), boff = lds_byte(wc * 32 + fr, fq * 8);
#define PG8_SA(b, h) (((b) * 2 + (h)) * HTB)
#define PG8_SB(b, h) ((4 + (b) * 2 + (h)) * HTB)
#define PG8_STAGE(bufoff, gbase, voff) do { _Pragma("unroll") for (int _i = 0; _i < 2; ++_i) \
        __builtin_amdgcn_global_load_lds((const unsigned*)((const char*)(gbase) + (voff)[_i]), (PG8_LAS unsigned*)(lds + (bufoff) + ldsw + _i * 8192), 16, 0, 0); } while (0)
#define PG8_LDA(dst, b, h) do { _Pragma("unroll") for (int m = 0; m < 4; ++m) _Pragma("unroll") for (int k = 0; k < 2; ++k) dst[m][k] = *(const PG8_LAS bf16x8*)(lds + PG8_SA(b, h) + aoff + m * 2048 + k * 1024); } while (0)
#define PG8_LDB(dst, b, h) do { _Pragma("unroll") for (int n = 0; n < 2; ++n) _Pragma("unroll") for (int k = 0; k < 2; ++k) dst[n][k] = *(const PG8_LAS bf16x8*)(lds + PG8_SB(b, h) + boff + n * 2048 + k * 1024); } while (0)
#define PG8_MMA(ai, bj, At, Bt) do { __builtin_amdgcn_s_setprio(1); _Pragma("unroll") for (int m = 0; m < 4; ++m) _Pragma("unroll") for (int n = 0; n < 2; ++n) _Pragma("unroll") for (int k = 0; k < 2; ++k) \
        acc[ai][bj][m][n] = __builtin_amdgcn_mfma_f32_16x16x32_bf16(Bt[n][k], At[m][k], acc[ai][bj][m][n], 0, 0, 0); __builtin_amdgcn_s_setprio(0); } while (0)
#define PG8_WAIT_V(n) asm volatile("s_waitcnt vmcnt(" #n ")" ::: "memory")
#define PG8_WAIT_L(n) asm volatile("s_waitcnt lgkmcnt(" #n ")" ::: "memory")
#define PG8_BAR __builtin_amdgcn_s_barrier()
#define PG8_SCHED __builtin_amdgcn_sched_barrier(0)
    Unit cur, nxt; int ui = 0;
    if (!S.next(0, cur)) return;
    f32x4 acc[2][2][4][2];
#pragma unroll
    for (int a = 0; a < 2; ++a)
#pragma unroll
        for (int b = 0; b < 2; ++b)
#pragma unroll
            for (int m = 0; m < 4; ++m)
#pragma unroll
                for (int n = 0; n < 2; ++n) acc[a][b][m][n] = (f32x4){0.f, 0.f, 0.f, 0.f};
    bf16x8 At[4][2], B0[2][2], B1[2][2];
    const char* cA = (const char*)g.A + (size_t)cur.pm * tstep; const char* cB = (const char*)g.Bt + (size_t)cur.pn * tstep;
    S.a_ready(cur);
    if constexpr (SP2) {
        PG8_STAGE(PG8_SB(0, 0), cB, voffB); PG8_STAGE(PG8_SB(0, 1), cB + hstep, voffB); PG8_STAGE(PG8_SA(0, 0), cA, voffA); PG8_STAGE(PG8_SA(0, 1), cA + hstep, voffA);
        if (wr == 1) PG8_BAR;
        PG8_WAIT_V(2); PG8_BAR;
        PG8_STAGE(PG8_SB(1, 0), cB + kstep, voffB); PG8_STAGE(PG8_SA(1, 0), cA + kstep, voffA); PG8_STAGE(PG8_SB(1, 1), cB + hstep + kstep, voffB);
        PG8_WAIT_V(6); PG8_BAR;
    } else {
        PG8_STAGE(PG8_SB(0, 0), cB, voffB); PG8_STAGE(PG8_SA(0, 0), cA, voffA); PG8_STAGE(PG8_SB(0, 1), cB + hstep, voffB); PG8_STAGE(PG8_SA(0, 1), cA + hstep, voffA);
        if (wr == 1) PG8_BAR;
        PG8_WAIT_V(4); PG8_BAR;
        PG8_STAGE(PG8_SB(1, 0), cB + kstep, voffB); PG8_STAGE(PG8_SA(1, 0), cA + kstep, voffA); PG8_STAGE(PG8_SB(1, 1), cB + hstep + kstep, voffB);
        PG8_WAIT_V(6); PG8_BAR;
    }
    for (;;) {
        const bool has_next = S.next(ui + 1, nxt);
        const char* nA = has_next ? (const char*)g.A + (size_t)nxt.pm * tstep : cA; const char* nB = has_next ? (const char*)g.Bt + (size_t)nxt.pn * tstep : cB;
        for (int t = 0; t < nt; t += 2) {
            const bool last = (t == nt - 2);
            const char* a1 = cA + (size_t)(t + 1) * kstep;
            const char* a2 = last ? nA : cA + (size_t)(t + 2) * kstep; const char* b2 = last ? nB : cB + (size_t)(t + 2) * kstep;
            const char* a3 = a2 + kstep; const char* b3 = b2 + kstep;
            if (last && has_next) S.a_ready(nxt);
            if constexpr (SP2) {
            PG8_LDB(B0, 0, 0); PG8_LDB(B1, 0, 1); PG8_SCHED; PG8_LDA(At, 0, 0); PG8_STAGE(PG8_SA(1, 1), a1 + hstep, voffA);
            PG8_WAIT_V(8); PG8_WAIT_L(0); PG8_BAR; PG8_MMA(0, 0, At, B0); PG8_MMA(0, 1, At, B1); PG8_BAR; PG8_SCHED;
            PG8_LDA(At, 0, 1); PG8_STAGE(PG8_SB(0, 0), b2, voffB); PG8_STAGE(PG8_SB(0, 1), b2 + hstep, voffB); PG8_STAGE(PG8_SA(0, 0), a2, voffA);
            PG8_WAIT_V(8); PG8_WAIT_L(0); PG8_BAR; PG8_MMA(1, 0, At, B0); PG8_MMA(1, 1, At, B1); PG8_BAR; PG8_SCHED;
            PG8_LDB(B0, 1, 0); PG8_LDB(B1, 1, 1); PG8_SCHED; PG8_LDA(At, 1, 0); PG8_STAGE(PG8_SA(0, 1), a2 + hstep, voffA);
            PG8_WAIT_V(8); PG8_WAIT_L(0); PG8_BAR; PG8_MMA(0, 0, At, B0); PG8_MMA(0, 1, At, B1); PG8_BAR; PG8_SCHED;
            PG8_LDA(At, 1, 1); PG8_STAGE(PG8_SB(1, 0), b3, voffB); PG8_STAGE(PG8_SB(1, 1), b3 + hstep, voffB); PG8_STAGE(PG8_SA(1, 0), a3, voffA);
            PG8_WAIT_V(8); PG8_WAIT_L(0); PG8_BAR; PG8_MMA(1, 0, At, B0); PG8_MMA(1, 1, At, B1); PG8_BAR; PG8_SCHED;
            } else {
            PG8_LDB(B0, 0, 0); PG8_SCHED; PG8_LDA(At, 0, 0); PG8_STAGE(PG8_SA(1, 1), a1 + hstep, voffA);
            PG8_WAIT_L(8); PG8_BAR; PG8_WAIT_L(0); PG8_MMA(0, 0, At, B0); PG8_BAR; PG8_SCHED;
            PG8_LDB(B1, 0, 1); PG8_STAGE(PG8_SB(0, 0), b2, voffB);
            PG8_BAR; PG8_WAIT_L(0); PG8_MMA(0, 1, At, B1); PG8_BAR;
            PG8_LDA(At, 0, 1); PG8_STAGE(PG8_SA(0, 0), a2, voffA);
            PG8_BAR; PG8_WAIT_L(0); PG8_MMA(1, 0, At, B0); PG8_BAR; PG8_SCHED;
            PG8_STAGE(PG8_SB(0, 1), b2 + hstep, voffB);
            PG8_WAIT_V(6); PG8_BAR; PG8_MMA(1, 1, At, B1); PG8_BAR;
            PG8_LDB(B0, 1, 0); PG8_SCHED; PG8_LDA(At, 1, 0); PG8_STAGE(PG8_SA(0, 1), a2 + hstep, voffA);
            PG8_WAIT_L(8); PG8_BAR; PG8_WAIT_L(0); PG8_MMA(0, 0, At, B0); PG8_BAR; PG8_SCHED;
            PG8_LDB(B1, 1, 1); PG8_STAGE(PG8_SB(1, 0), b3, voffB);
            PG8_BAR; PG8_WAIT_L(0); PG8_MMA(0, 1, At, B1); PG8_BAR;
            PG8_LDA(At, 1, 1); PG8_STAGE(PG8_SA(1, 0), a3, voffA);
            PG8_BAR; PG8_WAIT_L(0); PG8_MMA(1, 0, At, B0); PG8_BAR; PG8_SCHED;
            PG8_STAGE(PG8_SB(1, 1), b3 + hstep, voffB);
            PG8_WAIT_V(6); PG8_BAR; PG8_MMA(1, 1, At, B1); PG8_BAR;
            }
        }
        if constexpr (ALIGN_EPI) { if (wr == 0) PG8_BAR; }
        if constexpr (!Epi::AFTER_DRAIN) { E(acc, cur, wr, wc, fr, fq); S.done(cur); }
        if (!has_next) break;
#pragma unroll
        for (int a = 0; a < 2; ++a)
#pragma unroll
            for (int b = 0; b < 2; ++b)
#pragma unroll
                for (int m = 0; m < 4; ++m)
#pragma unroll
                    for (int n = 0; n < 2; ++n) acc[a][b][m][n] = (f32x4){0.f, 0.f, 0.f, 0.f};
        cur = nxt; cA = nA; cB = nB; ++ui;
        if constexpr (ALIGN_EPI) { if (wr == 1) PG8_BAR; }
    }
    PG8_WAIT_V(0);
    if constexpr (!ALIGN_EPI) { if (wr == 0) PG8_BAR; }
    PG8_BAR;
    if constexpr (Epi::AFTER_DRAIN) { E.fused(acc, cur, wr, wc, fr, fq, lds, wid, lane); S.done(cur); }
#undef PG8_SA
#undef PG8_SB
#undef PG8_STAGE
#undef PG8_LDA
#undef PG8_LDB
#undef PG8_MMA
#undef PG8_WAIT_V
#undef PG8_WAIT_L
#undef PG8_BAR
#undef PG8_SCHED
}
}
typedef float f32x2 __attribute__((ext_vector_type(2)));
constexpr int NWAVES = 8;
constexpr int BATCH = 8, SEQ = 2048, M = BATCH * SEQ, D = 4096, FF = 11008, NUP = 2 * FF, NIN = 11264, NIN_SRC = 11272, DEPTH = 2;
constexpr int DL = 1024, DFX = 1024, DDL = 2048, NFX = 8, NDL = 16, HD = 128;
constexpr int C_XA = 0, C_GA = 1024, C_QF = 2048, C_KF = 3072, C_VF = 4096, C_QD = 5120, C_KD = 7168, C_VD = 9216;
constexpr int SRC_FF_COL = 5120;
constexpr float EPS = 1e-6f;
constexpr float ATT_SCALE = 0.08838834764831845f;

constexpr size_t MiB = 1u << 20;
constexpr size_t WS_CTL = 0, CTL_ZERO_BYTES = 256 * 1024;
constexpr size_t WS_ROPE = 1 * MiB;
constexpr size_t WS_WFF = WS_ROPE + 256 * 1024;
constexpr size_t WS_LF = 2 * MiB;
constexpr size_t WS_CUM = WS_LF + 512 * 1024;
constexpr size_t WS_W1T = 4 * MiB;
constexpr size_t WS_W2T = WS_W1T + (size_t)4 * NUP * D * 2;
constexpr size_t WS_WIN = WS_W2T + (size_t)4 * D * FF * 2;
constexpr size_t WS_WOUT = WS_WIN + (size_t)2 * NIN * D * 2;
constexpr size_t WS_A1 = WS_WOUT + (size_t)2 * D * D * 2;
constexpr size_t WS_R = WS_A1 + (size_t)M * D * 2;
constexpr size_t WS_ACT = WS_R;
constexpr size_t WS_PROJ = WS_R;
constexpr size_t WS_HL = WS_PROJ + (size_t)M * NIN * 2;
constexpr size_t WS_PP = WS_HL + (size_t)M * DL * 4;
constexpr size_t WS_YB = WS_PP + (size_t)M * DL * 4;
constexpr size_t WS_YC = WS_YB + (size_t)M * DFX * 4;
constexpr size_t WS_END = WS_YC + (size_t)M * DDL * 4;
static_assert(WS_ACT + (size_t)M * FF * 2 <= WS_END && WS_CUM + 512 * 1024 <= WS_W1T, "d_ws map");
constexpr int CW_TMO = 0, CW_CODE = 1;
constexpr int CW_BAR = 4096;
constexpr int MAX_LAUNCHES = 8;

constexpr int RING_OFF = 0, RING_BYTES = 131072;
constexpr int LDSCTL_OFF = RING_BYTES, MISC_OFF = LDSCTL_OFF + 320;
constexpr int QS_OFF = RING_BYTES + 1024;
constexpr int LDS_BYTES = 147456;
static_assert(MISC_OFF + 128 <= QS_OFF && QS_OFF + 8192 <= LDS_BYTES, "LDS map");

#define GAS __attribute__((address_space(1)))
#define LAS __attribute__((address_space(3)))
typedef unsigned short bf16;
typedef unsigned v4u __attribute__((ext_vector_type(4)));
typedef float f32x4 __attribute__((ext_vector_type(4)));
typedef short bf16x8 __attribute__((ext_vector_type(8)));
typedef GAS unsigned gu32;
typedef GAS unsigned long long gu64;
#define RLX_AGENT __ATOMIC_RELAXED, __HIP_MEMORY_SCOPE_AGENT
#define LDS_WAIT() asm volatile("s_waitcnt lgkmcnt(0)" ::: "memory")
#define VM_WAIT() asm volatile("s_waitcnt vmcnt(0)" ::: "memory")
__device__ __forceinline__ unsigned long long rt() { return __builtin_amdgcn_s_memrealtime(); }
__device__ __forceinline__ unsigned f2bf(float f) { unsigned u = __builtin_bit_cast(unsigned, f); return (u + 0x7fffu + ((u >> 16) & 1u)) >> 16; }
__device__ __forceinline__ unsigned pk2(float lo, float hi) { return f2bf(lo) | (f2bf(hi) << 16); }

#define XB_TMO      128
#define XB_XCNT(j)  (256  + 64 * (j))
#define XB_XSUB(j)  (1280 + 64 * (j))
#define XB_XGEN(j)  (2304 + 64 * (j))
#define XB_TOP      3328
#define XB_TOPGEN   3392
#define XCD_BAR_WORDS 3456
#define XB_SPIN_CAP (1u << 18)

__device__ __forceinline__ unsigned xb_ld(unsigned* p)              { return __hip_atomic_load(p, __ATOMIC_RELAXED, __HIP_MEMORY_SCOPE_AGENT); }
__device__ __forceinline__ unsigned xb_add(unsigned* p, unsigned v) { return __hip_atomic_fetch_add(p, v, __ATOMIC_RELAXED, __HIP_MEMORY_SCOPE_AGENT); }
__device__ __forceinline__ unsigned xb_xcc_id() { return (unsigned)__builtin_amdgcn_s_getreg((3 << 11) | 20) & 0xFu; }
#define XB_SPIN(cond, bar) do { unsigned _sp = 0; while (cond) { __builtin_amdgcn_s_sleep(1); \
    if ((++_sp & 255u) == 0u) { if (xb_ld(&(bar)[XB_TMO])) break; if (_sp > XB_SPIN_CAP) { atomicAdd(&(bar)[XB_TMO], 1u); break; } } } } while (0)

struct XcdBarrier {
    unsigned* bar; unsigned x;
    volatile LAS unsigned* st;
};

__device__ __forceinline__ XcdBarrier xcd_barrier_post(unsigned* bar, volatile LAS unsigned* st) {
    XcdBarrier b; b.bar = bar; b.x = xb_xcc_id(); b.st = st;
    if (threadIdx.x == 0) (void)xb_add(&bar[XB_XCNT(b.x)], 1u);
    return b;
}
__device__ __forceinline__ void xcd_barrier_complete(unsigned* bar, unsigned x, unsigned& nloc, unsigned& nx) {
    const unsigned G = gridDim.x * gridDim.y * gridDim.z;
    unsigned sum, cnt, mine, sp = 0u;
    for (;;) {
        sum = 0u; cnt = 0u; mine = 0u;
#pragma unroll
        for (unsigned j = 0; j < 16; ++j) { const unsigned c = xb_ld(&bar[XB_XCNT(j)]); sum += c; cnt += (c > 0u) ? 1u : 0u; mine = (j == x) ? c : mine; }
        if (sum == G) break;
        __builtin_amdgcn_s_sleep(1);
        if ((++sp & 255u) == 0u) { if (xb_ld(&bar[XB_TMO])) break; if (sp > XB_SPIN_CAP) { atomicAdd(&bar[XB_TMO], 1u); break; } }
    }
    nloc = mine > 0u ? mine : 1u; nx = cnt > 0u ? cnt : 1u;
}

__device__ __forceinline__ void xcd_barrier(const XcdBarrier& b) {
    asm volatile("s_waitcnt vmcnt(0)" ::: "memory");
    __syncthreads();
    if (threadIdx.x == 0) {
        unsigned* bar = b.bar;
        __builtin_amdgcn_s_waitcnt(0);
        unsigned nloc = b.st[0], nx = b.st[1];
        if (nloc == 0u) { xcd_barrier_complete(bar, b.x, nloc, nx); b.st[0] = nloc; b.st[1] = nx; }
        const unsigned old = xb_add(&bar[XB_XSUB(b.x)], 1u);
        const unsigned gen = old / nloc;
        if (old + 1u == (gen + 1u) * nloc) {
            __builtin_amdgcn_fence(__ATOMIC_RELEASE, "agent");
            asm volatile("s_waitcnt vmcnt(0)" ::: "memory");
            const unsigned og = xb_add(&bar[XB_TOP], 1u);
            const unsigned tg = og / nx;
            if (og + 1u == (tg + 1u) * nx) xb_add(&bar[XB_TOPGEN], 1u);
            else XB_SPIN(xb_ld(&bar[XB_TOPGEN]) == tg, bar);
            __builtin_amdgcn_fence(__ATOMIC_ACQUIRE, "agent");
            xb_add(&bar[XB_XGEN(b.x)], 1u);
            asm volatile("s_waitcnt vmcnt(0)" ::: "memory");
        } else {
            XB_SPIN(xb_ld(&bar[XB_XGEN(b.x)]) == gen, bar);
            __builtin_amdgcn_fence(__ATOMIC_ACQUIRE, "agent");
            asm volatile("s_waitcnt vmcnt(0)" ::: "memory");
        }
    }
    __syncthreads();
}
static_assert((CW_BAR + MAX_LAUNCHES * XCD_BAR_WORDS) * 4 <= (int)CTL_ZERO_BYTES, "CTL words inside the memset region");

struct Frame {
    LAS unsigned char* lds;
    int tid, lane, wave;
    int vcu, G, bx;
};
__device__ __forceinline__ float wave_sum(float v) {
#pragma unroll
    for (int o = 1; o < 64; o <<= 1) v += __shfl_xor(v, o);
    return v;
}
__device__ __forceinline__ float wave_max(float v) {
#pragma unroll
    for (int o = 1; o < 64; o <<= 1) v = fmaxf(v, __shfl_xor(v, o));
    return v;
}
__device__ __forceinline__ float bf_lo(unsigned w) { return __builtin_bit_cast(float, w << 16); }
__device__ __forceinline__ float bf_hi(unsigned w) { return __builtin_bit_cast(float, w & 0xffff0000u); }
__device__ __forceinline__ float bf2f(bf16 b) { return __builtin_bit_cast(float, (unsigned)b << 16); }

__device__ __forceinline__ void transpose64(const float* __restrict__ W, int ldw, int src_col0, int k0, bf16* __restrict__ WT, int K, int dest_row0, LAS unsigned* scr, int lane) {
    const int q = lane & 15, r = lane >> 4;
#pragma unroll
    for (int p = 0; p < 8; ++p) { const int kr = 8 * p + 2 * r;
        const f32x4 a = *(const f32x4*)(W + (size_t)(k0 + kr) * ldw + src_col0 + 4 * q);
        const f32x4 b = *(const f32x4*)(W + (size_t)(k0 + kr + 1) * ldw + src_col0 + 4 * q);
        const int kp = 4 * p + r;
#pragma unroll
        for (int j = 0; j < 4; ++j) scr[(4 * q + j) * 33 + kp] = pg8::cvt_pk_bf16(a[j], b[j]); }
    LDS_WAIT(); asm volatile("" ::: "memory");
    const int c = lane & 7;
#pragma unroll
    for (int jj = 0; jj < 8; ++jj) { const int n = (lane >> 3) + 8 * jj; const LAS unsigned* s = scr + n * 33 + 4 * c;
        v4u o; o.x = s[0]; o.y = s[1]; o.z = s[2]; o.w = s[3];
        *(v4u*)(WT + (size_t)(dest_row0 + n) * K + k0 + 8 * c) = o; }
    LDS_WAIT(); asm volatile("" ::: "memory");
}
struct Args { const float* in[22]; float* out; unsigned char* ws; int ph_lo, ph_hi, li, pad; };
__device__ __forceinline__ void transpose_job(const Frame& F, const float* W, int ldw, int K, int Ndest, bf16* WT, int kind) {
    LAS unsigned* scr = (LAS unsigned*)(F.lds + RING_OFF) + F.wave * (64 * 33);
    const int gw = F.vcu * NWAVES + F.wave, NGW = F.G * NWAVES;
    const int nnb = Ndest / 64, nitems = (K / 64) * nnb;
    for (int it = gw; it < nitems; it += NGW) {
        const int kb = it / nnb, nb = it - kb * nnb, n0 = nb * 64;
        int src;
        if (kind == 0) { const int pn = n0 >> 8, within = n0 & 255; src = (within >> 7) * FF + pn * 128 + (within & 127); }
        else if (kind == 2) src = n0 < SRC_FF_COL ? n0 : n0 + 8;
        else src = n0;
        transpose64(W, ldw, src, kb * 64, WT, K, n0, scr, F.lane);
    }
}
__device__ __forceinline__ void p0_prologue(const Frame& F, const Args& P) {
    unsigned char* ws = P.ws;
    for (int fi = 0; fi < 4; ++fi) { const int l = fi >> 1, wh = fi & 1;
        transpose_job(F, P.in[wh ? 19 : 2] + (size_t)l * D * NUP, NUP, D, NUP, (bf16*)(ws + WS_W1T) + (size_t)fi * NUP * D, 0);
        transpose_job(F, P.in[wh ? 20 : 3] + (size_t)l * FF * D, D, FF, D, (bf16*)(ws + WS_W2T) + (size_t)fi * D * FF, 1); }
    for (int l = 0; l < DEPTH; ++l) {
        transpose_job(F, P.in[5] + (size_t)l * D * NIN_SRC, NIN_SRC, D, NIN, (bf16*)(ws + WS_WIN) + (size_t)l * NIN * D, 2);
        transpose_job(F, P.in[17] + (size_t)l * D * D, D, D, D, (bf16*)(ws + WS_WOUT) + (size_t)l * D * D, 1); }
    const int gt = F.bx * (NWAVES * 64) + F.tid, NGT = F.G * NWAVES * 64;
    float* wff = (float*)(ws + WS_WFF);
    for (int i = gt; i < DEPTH * 8 * D; i += NGT) { const int l = i / (8 * D), j = (i / D) & 7, k = i % D;
        wff[i] = P.in[5][(size_t)l * D * NIN_SRC + (size_t)k * NIN_SRC + SRC_FF_COL + j]; }
    float* rc = (float*)(ws + WS_ROPE); float* rs = rc + SEQ * 16;
    for (int i = gt; i < SEQ * 16; i += NGT) { const int pos = i >> 4, fi = i & 15;
        const float inv = 1.0f / powf(500000.0f, (float)(2 * fi) / 32.0f); const float ang = (float)pos * inv;
        rc[i] = cosf(ang); rs[i] = sinf(ang); }
}

template <bool WITH_FF>
__device__ __forceinline__ void norm_rows(const Frame& F, const float* __restrict__ src, const float* __restrict__ gain, bf16* __restrict__ dst,
                                          const float* __restrict__ wff, const float* __restrict__ bff, float* __restrict__ lf) {
    LAS float* wl = (LAS float*)(F.lds + RING_OFF);
    if (WITH_FF) { for (int i = F.tid; i < 8 * D / 4; i += NWAVES * 64) ((LAS f32x4*)wl)[i] = ((const f32x4*)wff)[i]; __syncthreads(); }
    const int gw = F.vcu * NWAVES + F.wave, NGW = F.G * NWAVES;
    for (int row = gw; row < M; row += NGW) {
        const f32x4* xr = (const f32x4*)(src + (size_t)row * D) + F.lane;
        f32x4 v[16]; float ss = 0.f;
#pragma unroll
        for (int j = 0; j < 16; ++j) { v[j] = xr[64 * j]; ss += (v[j].x * v[j].x + v[j].y * v[j].y) + (v[j].z * v[j].z + v[j].w * v[j].w); }
        const float rstd = 1.0f / sqrtf(wave_sum(ss) * (1.0f / D) + EPS);
        const f32x4* gr = (const f32x4*)gain + F.lane;
        unsigned long long* o8 = (unsigned long long*)(dst + (size_t)row * D) + F.lane;
#pragma unroll
        for (int j = 0; j < 16; ++j) { v[j] = v[j] * rstd * gr[64 * j];
            o8[64 * j] = (unsigned long long)pg8::cvt_pk_bf16(v[j].x, v[j].y) | ((unsigned long long)pg8::cvt_pk_bf16(v[j].z, v[j].w) << 32); }
        if (WITH_FF) {
            float a8[8];
#pragma unroll
            for (int h = 0; h < 8; ++h) { float a = 0.f;
#pragma unroll
                for (int j = 0; j < 16; ++j) { const f32x4 w = ((const LAS f32x4*)(wl + h * D))[F.lane + 64 * j]; a += (v[j].x * w.x + v[j].y * w.y) + (v[j].z * w.z + v[j].w * w.w); }
                a8[h] = wave_sum(a); }
            float mine = a8[0];
#pragma unroll
            for (int h = 1; h < 8; ++h) mine = (F.lane == h) ? a8[h] : mine;
            if (F.lane < 8) { const float z = mine + bff[F.lane]; lf[(size_t)row * 8 + F.lane] = fminf(z, 0.f) - log1pf(expf(-fabsf(z))); }
        }
    }
    if (WITH_FF) __syncthreads();
}
__device__ __forceinline__ void final_norm_rows(const Frame& F, float* __restrict__ x, const float* __restrict__ gain) {
    const int gw = F.vcu * NWAVES + F.wave, NGW = F.G * NWAVES;
    for (int row = gw; row < M; row += NGW) {
        f32x4* xr = (f32x4*)(x + (size_t)row * D) + F.lane;
        f32x4 v[16]; float ss = 0.f;
#pragma unroll
        for (int j = 0; j < 16; ++j) { v[j] = xr[64 * j]; ss += (v[j].x * v[j].x + v[j].y * v[j].y) + (v[j].z * v[j].z + v[j].w * v[j].w); }
        const float rstd = 1.0f / sqrtf(wave_sum(ss) * (1.0f / D) + EPS);
        const f32x4* gr = (const f32x4*)gain + F.lane;
#pragma unroll
        for (int j = 0; j < 16; ++j) xr[64 * j] = v[j] * rstd * gr[64 * j];
    }
}
__device__ __forceinline__ void cumsum_lf(const Frame& F, const float* __restrict__ lf, float* __restrict__ cum, int bh) {
    const int b = bh >> 3, h = bh & 7; const size_t base = ((size_t)b * SEQ + 32 * F.lane) * 8 + h;
    float loc[32]; float run = 0.f;
#pragma unroll
    for (int i = 0; i < 32; ++i) { run += lf[base + (size_t)i * 8]; loc[i] = run; }
    float inc = run;
#pragma unroll
    for (int o = 1; o < 64; o <<= 1) { const float t = __shfl_up(inc, o); if (F.lane >= o) inc += t; }
    const float excl = inc - run;
#pragma unroll
    for (int i = 0; i < 32; ++i) cum[base + (size_t)i * 8] = excl + loc[i];
}
__device__ __forceinline__ float sigmoidf_(float x) { return 1.0f / (1.0f + expf(-x)); }
__device__ __forceinline__ float gelu_tanh(float x) { return 0.5f * x * (1.0f + tanhf(0.7978845608028654f * (x + 0.044715f * x * x * x))); }

__device__ __forceinline__ void lru_unit(const Frame& F, const Args& P, int l, int u) {
    const int g = u & 7, c = (u >> 3) & 31, b = u >> 8;
    const int t0 = c * 64; const size_t row0 = (size_t)b * SEQ + t0;
    const bf16* proj = (const bf16*)(P.ws + WS_PROJ);
    float* HL = (float*)(P.ws + WS_HL); float* PPp = (float*)(P.ws + WS_PP);
    LAS float* xc = (LAS float*)(F.lds + RING_OFF);
    LAS float* Al = (LAS float*)(F.lds + RING_OFF + 32768);
    LAS float* Ul = (LAS float*)(F.lds + RING_OFF + 65536);
    LAS bf16* xs = (LAS bf16*)(F.lds + RING_OFF + 98304);
    for (int i = F.tid; i < 67 * 16; i += NWAVES * 64) { const int r = i >> 4, c8 = i & 15; const int t = t0 - 3 + r; v4u val = {0u, 0u, 0u, 0u};
        if (t >= 0) val = *(const v4u*)(proj + ((size_t)b * SEQ + t) * NIN + C_XA + g * 128 + c8 * 8);
        ((LAS v4u*)xs)[i] = val; }
    __syncthreads();
    const int ch = F.tid & 127, tq = F.tid >> 7, gch = g * 128 + ch;
    { const float* cw = P.in[6] + (size_t)l * 4 * DL; const float cb = P.in[7][l * DL + gch];
      const float w0 = cw[gch], w1 = cw[DL + gch], w2 = cw[2 * DL + gch], w3 = cw[3 * DL + gch];
#pragma unroll 4
      for (int tt = 0; tt < 16; ++tt) { const int t = tq * 16 + tt;
          xc[t * 128 + ch] = cb + w0 * bf2f(xs[t * 128 + ch]) + w1 * bf2f(xs[(t + 1) * 128 + ch]) + w2 * bf2f(xs[(t + 2) * 128 + ch]) + w3 * bf2f(xs[(t + 3) * 128 + ch]); } }
    __syncthreads();
    float ra[16], ia[16];
#pragma unroll
    for (int tt = 0; tt < 16; ++tt) { ra[tt] = 0.f; ia[tt] = 0.f; }
    { const float* wa = P.in[8] + ((size_t)l * 8 + g) * 128 * 128 + ch; const float* wx = P.in[10] + ((size_t)l * 8 + g) * 128 * 128 + ch;
#pragma unroll 1
      for (int i4 = 0; i4 < 32; ++i4) {
          const float a0 = wa[(4 * i4 + 0) * 128], a1 = wa[(4 * i4 + 1) * 128], a2 = wa[(4 * i4 + 2) * 128], a3 = wa[(4 * i4 + 3) * 128];
          const float x0 = wx[(4 * i4 + 0) * 128], x1 = wx[(4 * i4 + 1) * 128], x2 = wx[(4 * i4 + 2) * 128], x3 = wx[(4 * i4 + 3) * 128];
#pragma unroll
          for (int tt = 0; tt < 16; ++tt) { const f32x4 xv = *(const LAS f32x4*)(xc + (tq * 16 + tt) * 128 + 4 * i4);
              ra[tt] += (xv.x * a0 + xv.y * a1) + (xv.z * a2 + xv.w * a3); ia[tt] += (xv.x * x0 + xv.y * x1) + (xv.z * x2 + xv.w * x3); } } }
    { const float ba = P.in[9][l * DL + gch], bx = P.in[11][l * DL + gch], lam = P.in[12][l * DL + gch];
      const float sp = log1pf(expf(-lam));
#pragma unroll
      for (int tt = 0; tt < 16; ++tt) { const int t = tq * 16 + tt;
          const float r = sigmoidf_(ra[tt] + ba), ig = sigmoidf_(ia[tt] + bx);
          const float la = -8.0f * r * sp, a = expf(la), mult = sqrtf(-expm1f(2.0f * la));
          Al[t * 128 + ch] = a; Ul[t * 128 + ch] = mult * (ig * xc[t * 128 + ch]); } }
    __syncthreads();
    if (F.tid < 128) { float h = 0.f, p = 1.f;
#pragma unroll 4
        for (int t = 0; t < 64; ++t) { const float a = Al[t * 128 + F.tid], uu = Ul[t * 128 + F.tid]; h = a * h + uu; p *= a; Ul[t * 128 + F.tid] = h; Al[t * 128 + F.tid] = p; } }
    __syncthreads();
    for (int i = F.tid; i < 2048; i += NWAVES * 64) { const int r = i >> 5, c4 = i & 31; const size_t o = (row0 + r) * DL + g * 128 + c4 * 4;
        *(f32x4*)(HL + o) = ((const LAS f32x4*)Ul)[i]; *(f32x4*)(PPp + o) = ((const LAS f32x4*)Al)[i]; }
    __syncthreads();
}

__device__ __forceinline__ float dot8(v4u kw, const LAS float* q) {
    const f32x4 qa = *(const LAS f32x4*)q, qb = *(const LAS f32x4*)(q + 4);
    return (bf_lo(kw.x) * qa.x + bf_hi(kw.x) * qa.y) + (bf_lo(kw.y) * qa.z + bf_hi(kw.y) * qa.w) + (bf_lo(kw.z) * qb.x + bf_hi(kw.z) * qb.y) + (bf_lo(kw.w) * qb.z + bf_hi(kw.w) * qb.w);
}
__device__ __forceinline__ void fox_naive_task(const Frame& F, const Args& P, int task) {
    const int i = task & 1023, h = (task >> 10) & 7, b = task >> 13;
    const int t0 = 2 * i, t1 = t0 + 1, lane = F.lane;
    const bf16* proj = (const bf16*)(P.ws + WS_PROJ); const float* cum = (const float*)(P.ws + WS_CUM); float* YB = (float*)(P.ws + WS_YB);
    LAS float* sc = (LAS float*)(F.lds + RING_OFF) + F.wave * 4096;
    LAS float* qs = (LAS float*)(F.lds + QS_OFF) + F.wave * 256;
    const size_t rb = (size_t)b * SEQ;
    { const unsigned w0 = *(const unsigned*)(proj + (rb + t0) * NIN + C_QF + h * 128 + 2 * lane), w1 = *(const unsigned*)(proj + (rb + t1) * NIN + C_QF + h * 128 + 2 * lane);
      qs[2 * lane] = bf_lo(w0); qs[2 * lane + 1] = bf_hi(w0); qs[128 + 2 * lane] = bf_lo(w1); qs[128 + 2 * lane + 1] = bf_hi(w1); }
    LDS_WAIT(); asm volatile("" ::: "memory");
    const float dq0 = cum[(rb + t0) * 8 + h], dq1 = cum[(rb + t1) * 8 + h];
    const float NEG = -__builtin_inff();
    float mx0 = NEG, mx1 = NEG; const int nk = t1 + 1;
    for (int kb = 0; kb < nk; kb += 64) { const int key = kb + lane; float s0 = NEG, s1 = NEG;
        if (key < nk) { const v4u* kp = (const v4u*)(proj + (rb + key) * NIN + C_KF + h * 128); float d0 = 0.f, d1 = 0.f;
#pragma unroll 4
            for (int c = 0; c < 16; ++c) { const v4u kw = kp[c]; d0 += dot8(kw, qs + 8 * c); d1 += dot8(kw, qs + 128 + 8 * c); }
            const float dk = cum[(rb + key) * 8 + h];
            s1 = d1 * ATT_SCALE + (dq1 - dk); if (key <= t0) s0 = d0 * ATT_SCALE + (dq0 - dk); }
        sc[2 * key] = s0; sc[2 * key + 1] = s1; mx0 = fmaxf(mx0, s0); mx1 = fmaxf(mx1, s1); }
    mx0 = wave_max(mx0); mx1 = wave_max(mx1);
    float l0 = 0.f, l1 = 0.f;
    for (int kb = 0; kb < nk; kb += 64) { const int key = kb + lane; const float p0 = expf(sc[2 * key] - mx0), p1 = expf(sc[2 * key + 1] - mx1); sc[2 * key] = p0; sc[2 * key + 1] = p1; l0 += p0; l1 += p1; }
    l0 = wave_sum(l0); l1 = wave_sum(l1);
    LDS_WAIT(); asm volatile("" ::: "memory");
    float o00 = 0.f, o01 = 0.f, o10 = 0.f, o11 = 0.f;
    const unsigned* vp = (const unsigned*)(proj + rb * NIN + C_VF + h * 128) + lane;
#pragma unroll 4
    for (int key = 0; key < nk; ++key) { const float p0 = sc[2 * key], p1 = sc[2 * key + 1]; const unsigned w = vp[(size_t)key * (NIN / 2)]; const float va = bf_lo(w), vb = bf_hi(w);
        o00 += p0 * va; o01 += p0 * vb; o10 += p1 * va; o11 += p1 * vb; }
    const float r0 = 1.0f / l0, r1 = 1.0f / l1;
    *(f32x2*)(YB + (rb + t0) * DFX + h * 128 + 2 * lane) = (f32x2){o00 * r0, o01 * r0};
    *(f32x2*)(YB + (rb + t1) * DFX + h * 128 + 2 * lane) = (f32x2){o10 * r1, o11 * r1};
    LDS_WAIT(); asm volatile("" ::: "memory");
}
__device__ __forceinline__ void dil_naive_task(const Frame& F, const Args& P, int task) {
    const int hh = task & 15, row = task >> 4, t = row & (SEQ - 1), lane = F.lane; const size_t rb = (size_t)(row - t);
    const bf16* proj = (const bf16*)(P.ws + WS_PROJ); float* YC = (float*)(P.ws + WS_YC);
    LAS float* sc = (LAS float*)(F.lds + RING_OFF) + F.wave * 4096;
    LAS float* qs = (LAS float*)(F.lds + QS_OFF) + F.wave * 256;
    { const unsigned w0 = *(const unsigned*)(proj + (size_t)row * NIN + C_QD + hh * 128 + 2 * lane); qs[2 * lane] = bf_lo(w0); qs[2 * lane + 1] = bf_hi(w0); }
    LDS_WAIT(); asm volatile("" ::: "memory");
    const float NEG = -__builtin_inff(); float mx = NEG;
#pragma unroll 1
    for (int c = 0; c < 7; ++c) { const int idx = c * 64 + lane; float s = NEG;
        if (idx < 387) { const int pi = idx / 129, j = idx - pi * 129; const int d = pi == 0 ? 1 : (pi == 1 ? 4 : 16); const int tk = t - j * d;
            if (tk >= 0) { const v4u* kp = (const v4u*)(proj + (rb + tk) * NIN + C_KD + hh * 128); float d0 = 0.f;
#pragma unroll 4
                for (int cc = 0; cc < 16; ++cc) d0 += dot8(kp[cc], qs + 8 * cc);
                s = d0 * ATT_SCALE; } }
        sc[idx] = s; mx = fmaxf(mx, s); }
    mx = wave_max(mx);
    float lsum = 0.f;
#pragma unroll 1
    for (int c = 0; c < 7; ++c) { const int idx = c * 64 + lane; const float p = expf(sc[idx] - mx); sc[idx] = p; lsum += p; }
    lsum = wave_sum(lsum);
    LDS_WAIT(); asm volatile("" ::: "memory");
    float o0 = 0.f, o1 = 0.f;
    const unsigned* vp = (const unsigned*)(proj + rb * NIN + C_VD + hh * 128) + lane;
#pragma unroll 1
    for (int pi = 0; pi < 3; ++pi) { const int d = pi == 0 ? 1 : (pi == 1 ? 4 : 16);
#pragma unroll 4
        for (int j = 0; j <= 128; ++j) { const int tk = t - j * d; if (tk < 0) break; const float p = sc[pi * 129 + j]; const unsigned w = vp[(size_t)tk * (NIN / 2)]; o0 += p * bf_lo(w); o1 += p * bf_hi(w); } }
    const float rl = 1.0f / lsum;
    *(f32x2*)(YC + (size_t)row * DDL + hh * 128 + 2 * lane) = (f32x2){o0 * rl, o1 * rl};
    LDS_WAIT(); asm volatile("" ::: "memory");
}

__device__ __forceinline__ void merge_unit(const Frame& F, const Args& P, int l, int u) {
    const int c = u & 31, b = u >> 5; const size_t rb = (size_t)b * SEQ;
    const bf16* proj = (const bf16*)(P.ws + WS_PROJ); const float* HL = (const float*)(P.ws + WS_HL); const float* PPp = (const float*)(P.ws + WS_PP);
    const float* YB = (const float*)(P.ws + WS_YB); const float* YC = (const float*)(P.ws + WS_YC); bf16* Y = (bf16*)(P.ws + WS_A1);
    LAS float* hin = (LAS float*)(F.lds + RING_OFF);
    for (int ch = F.tid; ch < DL; ch += NWAVES * 64) { float h = 0.f;
        for (int cc = 0; cc < c; ++cc) { const size_t r = (rb + 64 * cc + 63) * DL + ch; h = PPp[r] * h + HL[r]; }
        hin[ch] = h; }
    __syncthreads();
    const float* g_a = P.in[14] + (size_t)l * DL; const float* g_b = P.in[15] + (size_t)l * DFX; const float* g_c = P.in[16] + (size_t)l * DDL;
    const int lane = F.lane;
    for (int rr = F.wave; rr < 64; rr += NWAVES) { const size_t row = rb + 64 * c + rr;
        { f32x4 y[4]; float ss = 0.f;
#pragma unroll
          for (int j = 0; j < 4; ++j) { const int chb = 4 * lane + 256 * j;
              const f32x4 hl = *(const f32x4*)(HL + row * DL + chb), pp = *(const f32x4*)(PPp + row * DL + chb), hi = *(const LAS f32x4*)(hin + chb);
              const uint2 gw = *(const uint2*)(proj + row * NIN + C_GA + chb);
              f32x4 hv = hl + pp * hi;
              y[j] = (f32x4){hv.x * gelu_tanh(bf_lo(gw.x)), hv.y * gelu_tanh(bf_hi(gw.x)), hv.z * gelu_tanh(bf_lo(gw.y)), hv.w * gelu_tanh(bf_hi(gw.y))};
              ss += (y[j].x * y[j].x + y[j].y * y[j].y) + (y[j].z * y[j].z + y[j].w * y[j].w); }
          const float rstd = 1.0f / sqrtf(wave_sum(ss) * (1.0f / DL) + EPS);
#pragma unroll
          for (int j = 0; j < 4; ++j) { const int chb = 4 * lane + 256 * j; const f32x4 o = y[j] * rstd * *(const f32x4*)(g_a + chb);
              *(unsigned long long*)(Y + row * D + chb) = (unsigned long long)pg8::cvt_pk_bf16(o.x, o.y) | ((unsigned long long)pg8::cvt_pk_bf16(o.z, o.w) << 32); } }
        { f32x4 y[4]; float ss = 0.f;
#pragma unroll
          for (int j = 0; j < 4; ++j) { const int chb = 4 * lane + 256 * j; y[j] = *(const f32x4*)(YB + row * DFX + chb);
              ss += (y[j].x * y[j].x + y[j].y * y[j].y) + (y[j].z * y[j].z + y[j].w * y[j].w); }
          const float rstd = 1.0f / sqrtf(wave_sum(ss) * (1.0f / DFX) + EPS);
#pragma unroll
          for (int j = 0; j < 4; ++j) { const int chb = 4 * lane + 256 * j; const f32x4 o = y[j] * rstd * *(const f32x4*)(g_b + chb);
              *(unsigned long long*)(Y + row * D + DL + chb) = (unsigned long long)pg8::cvt_pk_bf16(o.x, o.y) | ((unsigned long long)pg8::cvt_pk_bf16(o.z, o.w) << 32); } }
        { f32x4 y[8]; float ss = 0.f;
#pragma unroll
          for (int j = 0; j < 8; ++j) { const int chb = 4 * lane + 256 * j; y[j] = *(const f32x4*)(YC + row * DDL + chb);
              ss += (y[j].x * y[j].x + y[j].y * y[j].y) + (y[j].z * y[j].z + y[j].w * y[j].w); }
          const float rstd = 1.0f / sqrtf(wave_sum(ss) * (1.0f / DDL) + EPS);
#pragma unroll
          for (int j = 0; j < 8; ++j) { const int chb = 4 * lane + 256 * j; const f32x4 o = y[j] * rstd * *(const f32x4*)(g_c + chb);
              *(unsigned long long*)(Y + row * D + DL + DFX + chb) = (unsigned long long)pg8::cvt_pk_bf16(o.x, o.y) | ((unsigned long long)pg8::cvt_pk_bf16(o.z, o.w) << 32); } }
    }
    __syncthreads();
}
__global__ void __launch_bounds__(NWAVES * 64, 2) hymba_fwd(Args args) {
    extern __shared__ __attribute__((aligned(16))) unsigned char lds[];
    Frame F;
#define FRESH_F() do { int tz_ = threadIdx.x; asm volatile("" : "+v"(tz_)); int g_ = gridDim.x, bx_ = blockIdx.x; asm volatile("" : "+s"(g_), "+s"(bx_)); \
        F.lds = (LAS unsigned char*)lds; F.tid = tz_; F.lane = tz_ & 63; F.wave = __builtin_amdgcn_readfirstlane(tz_ >> 6); F.G = g_; F.bx = bx_; \
        F.vcu = (g_ % 8 == 0) ? (bx_ % 8) * (g_ / 8) + bx_ / 8 : bx_; } while (0)
    FRESH_F();
    const Args& P = args;
    unsigned char* ws = args.ws;
    gu32* ctl = (gu32*)(ws + WS_CTL);
    volatile LAS unsigned* MISC = (volatile LAS unsigned*)(F.lds + MISC_OFF);
    for (int u = F.tid; u < (LDS_BYTES - LDSCTL_OFF) / 4; u += NWAVES * 64) ((LAS unsigned*)(F.lds + LDSCTL_OFF))[u] = 0u;
    __syncthreads();
    XcdBarrier bar = xcd_barrier_post((unsigned*)(ctl + CW_BAR) + args.li * XCD_BAR_WORDS, MISC + 8);
    const int lo = args.ph_lo, hi = args.ph_hi;
    int pc = 0;
#define PH_ON() (pc >= lo && pc < hi)
#ifndef EN_MASK
#define EN_MASK 0x3ff
#endif
#define EN(k) (((EN_MASK) >> (k)) & 1)
#define PH_END() do { if (PH_ON() && pc + 1 < hi) xcd_barrier(bar); ++pc; } while (0)

    bf16* W1T = (bf16*)(ws + WS_W1T); bf16* W2T = (bf16*)(ws + WS_W2T); bf16* WIN = (bf16*)(ws + WS_WIN); bf16* WOUT = (bf16*)(ws + WS_WOUT);
    bf16* A1 = (bf16*)(ws + WS_A1); bf16* ACT = (bf16*)(ws + WS_ACT); bf16* PROJ = (bf16*)(ws + WS_PROJ);
    const float* rope_c = (const float*)(ws + WS_ROPE); const float* rope_s = rope_c + SEQ * 16;
    float* LFp = (float*)(ws + WS_LF); float* CUMp = (float*)(ws + WS_CUM);

    if (PH_ON() && EN(0)) { FRESH_F(); p0_prologue(F, P); }
    PH_END();

#pragma unroll 1
    for (int fi = 0; fi < 4; ++fi) {
        const int l = fi >> 1, wh = fi & 1;
        if (PH_ON() && EN(1)) { FRESH_F(); norm_rows<false>(F, fi == 0 ? P.in[0] : P.out, P.in[wh ? 18 : 1] + (size_t)l * D, A1, nullptr, nullptr, nullptr); }
        PH_END();
        if (PH_ON() && EN(2)) { FRESH_F(); pg8::Gemm g{A1, W1T + (size_t)fi * NUP * D, M, NUP, D}; pg8::StaticOrder S; S.init(M, NUP, F.G, (int)F.bx);
            pg8::EpiSwiglu E{ACT, FF};
            pg8::gemm_phase<pg8::EpiSwiglu, pg8::StaticOrder, true, true>(F.lds + RING_OFF, g, S, E); }
        PH_END();
        if (PH_ON() && EN(3)) { FRESH_F(); pg8::Gemm g{ACT, W2T + (size_t)fi * D * FF, M, D, FF}; pg8::StaticOrder S; S.init(M, D, F.G, (int)F.bx);
            pg8::EpiResid E{fi == 0 ? P.in[0] : P.out, P.out, D, 0.5f};
            pg8::gemm_phase<pg8::EpiResid, pg8::StaticOrder, true, true>(F.lds + RING_OFF, g, S, E); }
        PH_END();
        if (wh == 0) {
            if (PH_ON() && EN(4)) { FRESH_F(); norm_rows<true>(F, P.out, P.in[4] + (size_t)l * D, A1, (const float*)(ws + WS_WFF) + (size_t)l * 8 * D, P.in[13] + l * 8, LFp); }
            PH_END();
            if (PH_ON() && EN(5)) { FRESH_F();
                if (F.bx < 64 && F.wave == 0) cumsum_lf(F, LFp, CUMp, (int)F.bx);
                if (F.G < 64 && F.bx == 0 && F.wave == 1) { for (int bh = F.G; bh < 64; ++bh) cumsum_lf(F, LFp, CUMp, bh); }
                pg8::Gemm g{A1, WIN + (size_t)l * NIN * D, M, NIN, D}; pg8::StaticOrder S; S.init(M, NIN, F.G, (int)F.bx);
                pg8::EpiProj E{PROJ, NIN, rope_c, rope_s, C_QD / 256, C_VD / 256};
                pg8::gemm_phase<pg8::EpiProj, pg8::StaticOrder, true, true>(F.lds + RING_OFF, g, S, E); }
            PH_END();
            if (PH_ON() && EN(6)) { FRESH_F();
                for (int u = F.bx; u < BATCH * 32 * 8; u += F.G) lru_unit(F, P, l, u);
                const int gw = F.vcu * NWAVES + F.wave, NGW = F.G * NWAVES;
                for (int t = gw; t < BATCH * NFX * (SEQ / 2); t += NGW) fox_naive_task(F, P, t);
                for (int t = gw; t < M * NDL; t += NGW) dil_naive_task(F, P, t);
                __syncthreads();
            }
            PH_END();
            if (PH_ON() && EN(7)) { FRESH_F(); for (int u = F.bx; u < BATCH * 32; u += F.G) merge_unit(F, P, l, u); }
            PH_END();
            if (PH_ON() && EN(8)) { FRESH_F(); pg8::Gemm g{A1, WOUT + (size_t)l * D * D, M, D, D}; pg8::StaticOrder S; S.init(M, D, F.G, (int)F.bx);
                pg8::EpiResid E{P.out, P.out, D, 1.0f};
                pg8::gemm_phase<pg8::EpiResid, pg8::StaticOrder, true, true>(F.lds + RING_OFF, g, S, E); }
            PH_END();
        }
    }
    if (PH_ON() && EN(9)) { FRESH_F(); final_norm_rows(F, P.out, P.in[21]); }
    PH_END();
#undef PH_ON
#undef PH_END
}

constexpr int N_PHASES = 1 + 4 * 3 + 2 * 5 + 1;
extern "C" void kernel_launch(void* const* d_in, const int* in_sizes, int n_in, void* d_out, int out_size, void* d_ws, size_t ws_size, hipStream_t stream) {
    static int grid = 0;
    if (grid == 0) {
        if (n_in != 22 || in_sizes[0] != M * D || out_size != M * D || ws_size < WS_END) {
            fprintf(stderr, "kernel_launch: shape/workspace mismatch: n_in %d in0 %d out %d ws %zu (need %zu); nothing launched\n", n_in, n_in > 0 ? in_sizes[0] : -1, out_size, ws_size, (size_t)WS_END); grid = -1; return; }
        int dev = 0, cus = 0, per_cu = 0;
        if (hipGetDevice(&dev) != hipSuccess || hipDeviceGetAttribute(&cus, hipDeviceAttributeMultiprocessorCount, dev) != hipSuccess) { grid = -1; return; }
        if (hipFuncSetAttribute((const void*)hymba_fwd, hipFuncAttributeMaxDynamicSharedMemorySize, LDS_BYTES) != hipSuccess) { fprintf(stderr, "kernel_launch: hipFuncSetAttribute failed\n"); grid = -1; return; }
        if (hipOccupancyMaxActiveBlocksPerMultiprocessor(&per_cu, (const void*)hymba_fwd, NWAVES * 64, LDS_BYTES) != hipSuccess || per_cu < 1) {
            fprintf(stderr, "kernel_launch: occupancy query reports %d workgroups per CU\n", per_cu); }
        (void)hipGetLastError();
        grid = cus;
    }
    if (grid < 0) return;
    if (hipMemsetAsync((char*)d_ws + WS_CTL, 0, CTL_ZERO_BYTES, stream) != hipSuccess) return;
    Args a{};
    for (int i = 0; i < 22; ++i) a.in[i] = (const float*)d_in[i];
    a.out = (float*)d_out; a.ws = (unsigned char*)d_ws;
#ifndef MK_CUTS
    a.ph_lo = 0; a.ph_hi = N_PHASES; a.li = 0; a.pad = 0;
    hipLaunchKernelGGL(hymba_fwd, dim3(grid), dim3(NWAVES * 64), LDS_BYTES, stream, a);
#else
    { const int cuts[] = {MK_CUTS, N_PHASES}; int lo = 0;
      for (int li = 0; li < (int)(sizeof(cuts) / sizeof(int)); ++li) { a.ph_lo = lo; a.ph_hi = cuts[li]; a.li = li; a.pad = 0; lo = cuts[li];
          hipLaunchKernelGGL(hymba_fwd, dim3(grid), dim3(NWAVES * 64), LDS_BYTES, stream, a); } }
#endif
}
```

```cpp
#include <hip/hip_runtime.h>
#include <cstdio>
#include <cstdint>
namespace pg8 {
#define PG8_LAS __attribute__((address_space(3)))
typedef unsigned short bf16_t;
typedef short bf16x8 __attribute__((ext_vector_type(8)));
typedef float f32x4 __attribute__((ext_vector_type(4)));
typedef unsigned u32x4 __attribute__((ext_vector_type(4)));
constexpr int BM = 256, BK = 64, HALF = 128, HTB = HALF * BK * 2  , STAGE_BYTES = 8 * HTB, NXCD = 8, WGM = 8;

__host__ __device__ __forceinline__ int lds_byte(int r, int c) { const int st = (r >> 4) * 2 + (c >> 5), rr = r & 15, cc = c & 31, ob = rr * 64 + cc * 2; return st * 1024 + (ob ^ (((ob >> 9) & 1) << 5)); }
__host__ __device__ __forceinline__ void stage_rc(int b, int& R, int& C) { const int st = b / 1024, sb = b % 1024, swz = sb ^ (((sb >> 9) & 1) << 5); R = (st >> 1) * 16 + swz / 64; C = (st & 1) * 32 + (swz % 64) / 2; }
__host__ __device__ __forceinline__ int perm32(int rho) { const int n = rho >> 4, i = rho & 15; return 8 * (i >> 2) + 4 * n + (i & 3); }

struct Unit { int pm, pn; };
struct Gemm { const bf16_t* A; const bf16_t* Bt; int M, N, K; };

struct StaticOrder {
    int nM, nN, nwg, G, c, wgm;
    __host__ __device__ void init(int M, int N, int G_, int c_, int wgm_ = WGM) { nM = M / BM; nN = N / BM; nwg = nM * nN; G = G_; c = c_; wgm = wgm_; }
    __host__ __device__ bool next(int i, Unit& u) const {
        const long L = (long)i * G + c; if (L >= nwg) return false;
        int wgid = (int)L; { const int q = nwg / NXCD, r = nwg % NXCD, xcd = wgid % NXCD, off = wgid / NXCD; wgid = (xcd < r ? xcd * (q + 1) : r * (q + 1) + (xcd - r) * q) + off; }
        const int nig = wgm * nN, gid = wgid / nig, fm = gid * wgm, gsz = (nM - fm) < wgm ? (nM - fm) : wgm;
        u.pm = fm + ((wgid % nig) % gsz); u.pn = (wgid % nig) / gsz; return true;
    }
    __device__ __forceinline__ void a_ready(const Unit&) const {}
    __device__ __forceinline__ void done(const Unit&) const {}
};

__device__ __forceinline__ unsigned cvt_pk_bf16(float lo, float hi) { unsigned r; asm volatile("v_cvt_pk_bf16_f32 %0, %1, %2" : "=v"(r) : "v"(lo), "v"(hi)); return r; }
typedef float f32x2 __attribute__((ext_vector_type(2)));
template <bool OUT8, bool I8 = false> struct EpiSwiglu {
    static constexpr bool PERM = true, AFTER_DRAIN = false, PROBE_TWICE = true;
    bf16_t* O; int ldc; const unsigned long long* ssq; float inv_k, eps, wscale, oscale; const float* ascale; const float* wmax;
    __device__ __forceinline__ void operator()(const f32x4 (&acc)[2][2][4][2], const Unit& u, int wr, int wc, int fr, int fq) const {
        const int row0 = u.pm * BM + wr * 64 + fr, col0 = u.pn * HALF + wc * 32 + 8 * fq;
        float rs[2][4];
#pragma unroll
        for (int ai = 0; ai < 2; ++ai)
#pragma unroll
            for (int m = 0; m < 4; ++m) { rs[ai][m] = __builtin_amdgcn_rsqf((float)(unsigned)(ssq[row0 + ai * HALF + m * 16] >> 12) * (inv_k * 4096.0f) + eps) * wscale; if constexpr (I8) rs[ai][m] *= ascale[row0 + ai * HALF + m * 16]; }
        const int cb_ = OUT8 ? (u.pn * HALF + wc * 32 + 8 * fq) : 2 * (u.pn * HALF + wc * 32 + 8 * fq);
        const size_t eb0 = ((size_t)(u.pm * ldc + (cb_ >> 7)) * 256 + wr * 64 + fr) * 128 + (cb_ & 127);
        f32x4 cg[2], cu[2];
        if constexpr (I8) {
#pragma unroll
            for (int n = 0; n < 2; ++n) { cg[n] = *(const f32x4*)(wmax + u.pn * BM + wc * 32 + 8 * fq + 4 * n) * (1.0f / 127.0f); cu[n] = *(const f32x4*)(wmax + u.pn * BM + HALF + wc * 32 + 8 * fq + 4 * n) * (1.0f / 127.0f); } }
#pragma unroll
        for (int ai = 0; ai < 2; ++ai)
#pragma unroll
            for (int m = 0; m < 4; ++m) {
                const size_t eoffb = eb0 + (size_t)((ai * HALF + m * 16) * 128);
                float r[8];
#pragma unroll
                for (int n = 0; n < 2; ++n)
#pragma unroll
                    for (int j = 0; j < 4; ++j) { float g = acc[ai][0][m][n][j], up = acc[ai][1][m][n][j];
                        if constexpr (I8) { g = (float)__float_as_int(g) * cg[n][j]; up = (float)__float_as_int(up) * cu[n][j]; }
                        r[n * 4 + j] = (g * up) * (__builtin_amdgcn_rcpf(1.0f + __builtin_amdgcn_exp2f(g * (rs[ai][m] * -1.4426950408889634f))) * (rs[ai][m] * rs[ai][m])); }
                if constexpr (OUT8) { int p0 = 0, p1 = 0;
                    p0 = __builtin_amdgcn_cvt_pk_fp8_f32(r[0] * oscale, r[1] * oscale, p0, false); p0 = __builtin_amdgcn_cvt_pk_fp8_f32(r[2] * oscale, r[3] * oscale, p0, true);
                    p1 = __builtin_amdgcn_cvt_pk_fp8_f32(r[4] * oscale, r[5] * oscale, p1, false); p1 = __builtin_amdgcn_cvt_pk_fp8_f32(r[6] * oscale, r[7] * oscale, p1, true);
                    typedef unsigned u32x2_ __attribute__((ext_vector_type(2)));
                    *(u32x2_*)((unsigned char*)O + eoffb) = (u32x2_){(unsigned)p0, (unsigned)p1}; }
                else { u32x4 w; w.x = cvt_pk_bf16(r[0], r[1]); w.y = cvt_pk_bf16(r[2], r[3]); w.z = cvt_pk_bf16(r[4], r[5]); w.w = cvt_pk_bf16(r[6], r[7]);
                    *(u32x4*)((unsigned char*)O + eoffb) = w; } }
    }
};
struct EpiResid {
    static constexpr bool PERM = false, AFTER_DRAIN = false, PROBE_TWICE = false;
    const float* base; float* out; int ldc; float s;
    __device__ __forceinline__ void operator()(const f32x4 (&acc)[2][2][4][2], const Unit& u, int wr, int wc, int fr, int fq) const {
        const int row0 = u.pm * BM + wr * 64 + fr, col0 = u.pn * BM + wc * 32 + 4 * fq;
#pragma unroll
        for (int ai = 0; ai < 2; ++ai) {
            f32x4 b[4][2][2];
#pragma unroll
            for (int m = 0; m < 4; ++m) { const size_t off = (size_t)(row0 + ai * HALF + m * 16) * ldc + col0;
#pragma unroll
                for (int bj = 0; bj < 2; ++bj)
#pragma unroll
                    for (int n = 0; n < 2; ++n) b[m][bj][n] = *(const f32x4*)(base + off + bj * HALF + n * 16); }
#pragma unroll
            for (int m = 0; m < 4; ++m) { const size_t off = (size_t)(row0 + ai * HALF + m * 16) * ldc + col0;
#pragma unroll
                for (int bj = 0; bj < 2; ++bj)
#pragma unroll
                    for (int n = 0; n < 2; ++n) *(f32x4*)(out + off + bj * HALF + n * 16) = b[m][bj][n] + acc[ai][bj][m][n] * s; }
            asm volatile("" ::: "memory"); }
    }
};
struct EpiDelta {
    static constexpr bool PERM = true, AFTER_DRAIN = false, PROBE_TWICE = false;
    bf16_t* O; int ldc; float s;
    __device__ __forceinline__ void operator()(const f32x4 (&acc)[2][2][4][2], const Unit& u, int wr, int wc, int fr, int fq) const {
        const int row0 = u.pm * BM + wr * 64 + fr, col0 = u.pn * BM + wc * 32 + 8 * fq;
#pragma unroll
        for (int ai = 0; ai < 2; ++ai)
#pragma unroll
            for (int m = 0; m < 4; ++m) { bf16_t* rowp = O + (size_t)(row0 + ai * HALF + m * 16) * ldc + col0;
#pragma unroll
                for (int bj = 0; bj < 2; ++bj) { const f32x4 v0 = acc[ai][bj][m][0] * s, v1 = acc[ai][bj][m][1] * s;
                    u32x4 w; w.x = cvt_pk_bf16(v0[0], v0[1]); w.y = cvt_pk_bf16(v0[2], v0[3]); w.z = cvt_pk_bf16(v1[0], v1[1]); w.w = cvt_pk_bf16(v1[2], v1[3]);
                    *(u32x4*)(rowp + bj * HALF) = w; } }
    }
};
struct EpiResidB {
    static constexpr bool PERM = true, AFTER_DRAIN = false, PROBE_TWICE = false;
    bf16_t* H; int ldc; float s; unsigned long long* ssq; unsigned char* H8;
    __device__ __forceinline__ void operator()(const f32x4 (&acc)[2][2][4][2], const Unit& u, int wr, int wc, int fr, int fq) const {
        const int row0 = u.pm * BM + wr * 64 + fr, col0 = u.pn * BM + wc * 32 + 8 * fq;
#pragma unroll
        for (int ai = 0; ai < 2; ++ai) {
            u32x4 hv[4][2];
#pragma unroll
            for (int m = 0; m < 4; ++m)
#pragma unroll
                for (int bj = 0; bj < 2; ++bj) hv[m][bj] = *(const u32x4*)(H + (size_t)(row0 + ai * HALF + m * 16) * ldc + col0 + bj * HALF);
#pragma unroll
            for (int m = 0; m < 4; ++m) { const int row = row0 + ai * HALF + m * 16; bf16_t* rowp = H + (size_t)row * ldc + col0; float q = 0.f;
#pragma unroll
                for (int bj = 0; bj < 2; ++bj) { const u32x4 h = hv[m][bj]; const f32x4 a0 = acc[ai][bj][m][0] * s, a1 = acc[ai][bj][m][1] * s;
                    u32x4 w;
                    w.x = cvt_pk_bf16(__uint_as_float(h.x << 16) + a0[0], __uint_as_float(h.x & 0xffff0000u) + a0[1]);
                    w.y = cvt_pk_bf16(__uint_as_float(h.y << 16) + a0[2], __uint_as_float(h.y & 0xffff0000u) + a0[3]);
                    w.z = cvt_pk_bf16(__uint_as_float(h.z << 16) + a1[0], __uint_as_float(h.z & 0xffff0000u) + a1[1]);
                    w.w = cvt_pk_bf16(__uint_as_float(h.w << 16) + a1[2], __uint_as_float(h.w & 0xffff0000u) + a1[3]);
                    *(u32x4*)(rowp + bj * HALF) = w;
                    float f8[8];
#pragma unroll
                    for (int e = 0; e < 4; ++e) { const float lo = __uint_as_float(w[e] << 16), hi = __uint_as_float(w[e] & 0xffff0000u); q += lo * lo + hi * hi; f8[2 * e] = lo; f8[2 * e + 1] = hi; }
}
                q += __shfl_xor(q, 16); q += __shfl_xor(q, 32);
                if (fq == 0) atomicAdd(ssq + row, (unsigned long long)(q * 1048576.0f + 0.5f)); }
            asm volatile("" ::: "memory"); }
    }
};
struct EpiProj {
    static constexpr bool PERM = true, AFTER_DRAIN = false, PROBE_TWICE = false;
    bf16_t* O; int ldc; const float* rope_cos; const float* rope_sin; int rope_lo, rope_hi; const unsigned long long* ssq; float inv_k, eps;
    __device__ __forceinline__ void operator()(const f32x4 (&acc)[2][2][4][2], const Unit& u, int wr, int wc, int fr, int fq) const {
        const int row0 = u.pm * BM + wr * 64 + fr, col0 = u.pn * BM + wc * 32 + 8 * fq;
        const bool do_rope = (u.pn >= rope_lo) && (u.pn < rope_hi) && (wc == 0);
        float rsd[2][4];
#pragma unroll
        for (int ai = 0; ai < 2; ++ai)
#pragma unroll
            for (int m = 0; m < 4; ++m) rsd[ai][m] = __builtin_amdgcn_rsqf((float)(unsigned)(ssq[row0 + ai * HALF + m * 16] >> 12) * (inv_k * 4096.0f) + eps);
#pragma unroll
        for (int ai = 0; ai < 2; ++ai)
#pragma unroll
          for (int mh = 0; mh < 2; ++mh) {
            f32x4 c0[2], c1[2], s0[2], s1[2];
            if (do_rope) {
#pragma unroll
                for (int mm = 0; mm < 2; ++mm) { const int pos = (row0 + ai * HALF + (2 * mh + mm) * 16) & 2047, i0 = (fq & 1) * 8;
                    c0[mm] = *(const f32x4*)(rope_cos + pos * 16 + i0); c1[mm] = *(const f32x4*)(rope_cos + pos * 16 + i0 + 4);
                    s0[mm] = *(const f32x4*)(rope_sin + pos * 16 + i0); s1[mm] = *(const f32x4*)(rope_sin + pos * 16 + i0 + 4);
                    if (fq < 2) { s0[mm] = -s0[mm]; s1[mm] = -s1[mm]; } } }
#pragma unroll
            for (int mm = 0; mm < 2; ++mm) { const int m = 2 * mh + mm; const int row = row0 + ai * HALF + m * 16; bf16_t* rowp = O + (size_t)row * ldc + col0;
#pragma unroll
                for (int bj = 0; bj < 2; ++bj) { f32x4 v0 = acc[ai][bj][m][0] * rsd[ai][m], v1 = acc[ai][bj][m][1] * rsd[ai][m];
                    if (do_rope) { f32x4 p0, p1;
#pragma unroll
                        for (int j = 0; j < 4; ++j) { p0[j] = __shfl_xor(v0[j], 32); p1[j] = __shfl_xor(v1[j], 32); }
                        v0 = v0 * c0[mm] + p0 * s0[mm]; v1 = v1 * c1[mm] + p1 * s1[mm]; }
                    u32x4 w; w.x = cvt_pk_bf16(v0[0], v0[1]); w.y = cvt_pk_bf16(v0[2], v0[3]); w.z = cvt_pk_bf16(v1[0], v1[1]); w.w = cvt_pk_bf16(v1[2], v1[3]);
                    *(u32x4*)(rowp + bj * HALF) = w; } }
            asm volatile("" ::: "memory"); }
    }
};

template <class Epi, class Sched, bool ALIGN_EPI = false, bool SP2 = false, bool F8 = false, bool I8 = false, bool TM = false>
__device__ __forceinline__ void gemm_phase(PG8_LAS unsigned char* lds, const Gemm g, const Sched& S, const Epi& E) {
    int tid_ = threadIdx.x; asm volatile("" : "+v"(tid_));
    const int tid = tid_, wid = __builtin_amdgcn_readfirstlane(tid >> 6), lane = tid & 63, wr = wid >> 2, wc = wid & 3, fr = lane & 15, fq = lane >> 4;
    const int K = g.K, nt = K / BK;
    unsigned voffA[2], voffB[2];
#pragma unroll
    for (int i = 0; i < 2; ++i) { int R, C; stage_rc(tid * 16 + i * 8192, R, C); const int Rb = Epi::PERM ? ((R & ~31) + perm32(R & 31)) : R;
        voffA[i] = TM ? (unsigned)(R * 128 + C * 2) : (unsigned)(R * K + C) * 2u; voffB[i] = TM ? (unsigned)(Rb * 128 + C * 2) : (unsigned)(Rb * K + C) * 2u; }
    const size_t kstep = TM ? (size_t)32768 : (size_t)(BK * 2);
    const size_t hstep = TM ? (size_t)16384 : (size_t)HALF * K * 2;
    const size_t tstep = TM ? (size_t)nt * 32768 : 2 * hstep;
    const unsigned ldsw = (unsigned)wid * 1024u;
    const int aoff = lds_byte(wr * 64 + fr, fq * 8), boff = lds_byte(wc * 32 + fr, fq * 8);
#define PG8_SA(b, h) (((b) * 2 + (h)) * HTB)
#define PG8_SB(b, h) ((4 + (b) * 2 + (h)) * HTB)
#define PG8_STAGE(bufoff, gbase, voff) do { _Pragma("unroll") for (int _i = 0; _i < 2; ++_i) \
        __builtin_amdgcn_global_load_lds((const unsigned*)((const char*)(gbase) + (voff)[_i]), (PG8_LAS unsigned*)(lds + (bufoff) + ldsw + _i * 8192), 16, 0, 0); } while (0)
#define PG8_LDA(dst, b, h) do { if constexpr (F8) { _Pragma("unroll") for (int m = 0; m < 4; ++m) dst##8[m] = PG8_CAT(*(const PG8_LAS bf16x8*)(lds + PG8_SA(b, h) + aoff + m * 2048), *(const PG8_LAS bf16x8*)(lds + PG8_SA(b, h) + aoff + m * 2048 + 1024)); } \
        else { _Pragma("unroll") for (int m = 0; m < 4; ++m) _Pragma("unroll") for (int k = 0; k < 2; ++k) dst[m][k] = *(const PG8_LAS bf16x8*)(lds + PG8_SA(b, h) + aoff + m * 2048 + k * 1024); } } while (0)
#define PG8_LDB(dst, b, h) do { if constexpr (F8) { _Pragma("unroll") for (int n = 0; n < 2; ++n) dst##8[n] = PG8_CAT(*(const PG8_LAS bf16x8*)(lds + PG8_SB(b, h) + boff + n * 2048), *(const PG8_LAS bf16x8*)(lds + PG8_SB(b, h) + boff + n * 2048 + 1024)); } \
        else { _Pragma("unroll") for (int n = 0; n < 2; ++n) _Pragma("unroll") for (int k = 0; k < 2; ++k) dst[n][k] = *(const PG8_LAS bf16x8*)(lds + PG8_SB(b, h) + boff + n * 2048 + k * 1024); } } while (0)
    typedef int pg8_v4i __attribute__((ext_vector_type(4))); typedef int pg8_v8i __attribute__((ext_vector_type(8)));
#define PG8_CAT(x0, x1) __builtin_shufflevector(__builtin_bit_cast(pg8_v4i, x0), __builtin_bit_cast(pg8_v4i, x1), 0, 1, 2, 3, 4, 5, 6, 7)
#define PG8_MMA(ai, bj, At, Bt) do { __builtin_amdgcn_s_setprio(1); \
        if constexpr (F8) { _Pragma("unroll") for (int m = 0; m < 4; ++m) _Pragma("unroll") for (int n = 0; n < 2; ++n) \
            asm volatile("v_mfma_scale_f32_16x16x128_f8f6f4 %0, %1, %2, %0, %3, %3 op_sel_hi:[0,0,0]" : "+v"(acc[ai][bj][m][n]) : "v"(Bt##8[n]), "v"(At##8[m]), "v"(f8_scale)); } \
        else if constexpr (I8) { _Pragma("unroll") for (int m = 0; m < 4; ++m) _Pragma("unroll") for (int n = 0; n < 2; ++n) _Pragma("unroll") for (int k = 0; k < 2; ++k) \
            acc[ai][bj][m][n] = __builtin_bit_cast(f32x4, __builtin_amdgcn_mfma_i32_16x16x64_i8(__builtin_bit_cast(pg8_v4i, Bt[n][k]), __builtin_bit_cast(pg8_v4i, At[m][k]), __builtin_bit_cast(pg8_v4i, acc[ai][bj][m][n]), 0, 0, 0)); } \
        else { _Pragma("unroll") for (int m = 0; m < 4; ++m) _Pragma("unroll") for (int n = 0; n < 2; ++n) _Pragma("unroll") for (int k = 0; k < 2; ++k) \
            acc[ai][bj][m][n] = __builtin_amdgcn_mfma_f32_16x16x32_bf16(Bt[n][k], At[m][k], acc[ai][bj][m][n], 0, 0, 0); } \
        __builtin_amdgcn_s_setprio(0); } while (0)
#define PG8_WAIT_V(n) asm volatile("s_waitcnt vmcnt(" #n ")" ::: "memory")
#define PG8_WAIT_L(n) asm volatile("s_waitcnt lgkmcnt(" #n ")" ::: "memory")
#define PG8_BAR __builtin_amdgcn_s_barrier()
#define PG8_SCHED __builtin_amdgcn_sched_barrier(0)
    Unit cur, nxt; int ui = 0;
    if (!S.next(0, cur)) return;
    f32x4 acc[2][2][4][2];
#pragma unroll
    for (int a = 0; a < 2; ++a)
#pragma unroll
        for (int b = 0; b < 2; ++b)
#pragma unroll
            for (int m = 0; m < 4; ++m)
#pragma unroll
                for (int n = 0; n < 2; ++n) acc[a][b][m][n] = (f32x4){0.f, 0.f, 0.f, 0.f};
    const int f8_scale = 0x7F7F7F7F;
    bf16x8 At[4][2], B0[2][2], B1[2][2]; pg8_v8i At8[4], B08[2], B18[2];
    const char* cA = (const char*)g.A + (size_t)cur.pm * tstep; const char* cB = (const char*)g.Bt + (size_t)cur.pn * tstep;
    S.a_ready(cur);
    if constexpr (SP2) {
        PG8_STAGE(PG8_SB(0, 0), cB, voffB); PG8_STAGE(PG8_SB(0, 1), cB + hstep, voffB); PG8_STAGE(PG8_SA(0, 0), cA, voffA); PG8_STAGE(PG8_SA(0, 1), cA + hstep, voffA);
        if (wr == 1) PG8_BAR;
        PG8_WAIT_V(2); PG8_BAR;
        PG8_STAGE(PG8_SB(1, 0), cB + kstep, voffB); PG8_STAGE(PG8_SA(1, 0), cA + kstep, voffA); PG8_STAGE(PG8_SB(1, 1), cB + hstep + kstep, voffB);
        PG8_WAIT_V(6); PG8_BAR;
    } else {
        PG8_STAGE(PG8_SB(0, 0), cB, voffB); PG8_STAGE(PG8_SA(0, 0), cA, voffA); PG8_STAGE(PG8_SB(0, 1), cB + hstep, voffB); PG8_STAGE(PG8_SA(0, 1), cA + hstep, voffA);
        if (wr == 1) PG8_BAR;
        PG8_WAIT_V(4); PG8_BAR;
        PG8_STAGE(PG8_SB(1, 0), cB + kstep, voffB); PG8_STAGE(PG8_SA(1, 0), cA + kstep, voffA); PG8_STAGE(PG8_SB(1, 1), cB + hstep + kstep, voffB);
        PG8_WAIT_V(6); PG8_BAR;
    }
    for (;;) {
        const bool has_next = S.next(ui + 1, nxt);
        const char* nA = has_next ? (const char*)g.A + (size_t)nxt.pm * tstep : cA; const char* nB = has_next ? (const char*)g.Bt + (size_t)nxt.pn * tstep : cB;
        for (int t = 0; t < nt; t += 2) {
            const bool last = (t == nt - 2);
            const char* a1 = cA + (size_t)(t + 1) * kstep;
            const char* a2 = last ? nA : cA + (size_t)(t + 2) * kstep; const char* b2 = last ? nB : cB + (size_t)(t + 2) * kstep;
            const char* a3 = a2 + kstep; const char* b3 = b2 + kstep;
            if (last && has_next) S.a_ready(nxt);
            if constexpr (SP2) {
            PG8_LDB(B0, 0, 0); PG8_LDB(B1, 0, 1); PG8_SCHED; PG8_LDA(At, 0, 0); PG8_STAGE(PG8_SA(1, 1), a1 + hstep, voffA);
            PG8_WAIT_V(8); PG8_WAIT_L(0); PG8_BAR; PG8_MMA(0, 0, At, B0); PG8_MMA(0, 1, At, B1); PG8_BAR; PG8_SCHED;
            PG8_LDA(At, 0, 1); PG8_STAGE(PG8_SB(0, 0), b2, voffB); PG8_STAGE(PG8_SB(0, 1), b2 + hstep, voffB); PG8_STAGE(PG8_SA(0, 0), a2, voffA);
            PG8_WAIT_V(8); PG8_WAIT_L(0); PG8_BAR; PG8_MMA(1, 0, At, B0); PG8_MMA(1, 1, At, B1); PG8_BAR; PG8_SCHED;
            PG8_LDB(B0, 1, 0); PG8_LDB(B1, 1, 1); PG8_SCHED; PG8_LDA(At, 1, 0); PG8_STAGE(PG8_SA(0, 1), a2 + hstep, voffA);
            PG8_WAIT_V(8); PG8_WAIT_L(0); PG8_BAR; PG8_MMA(0, 0, At, B0); PG8_MMA(0, 1, At, B1); PG8_BAR; PG8_SCHED;
            PG8_LDA(At, 1, 1); PG8_STAGE(PG8_SB(1, 0), b3, voffB); PG8_STAGE(PG8_SB(1, 1), b3 + hstep, voffB); PG8_STAGE(PG8_SA(1, 0), a3, voffA);
            PG8_WAIT_V(8); PG8_WAIT_L(0); PG8_BAR; PG8_MMA(1, 0, At, B0); PG8_MMA(1, 1, At, B1); PG8_BAR; PG8_SCHED;
            } else {
            PG8_LDB(B0, 0, 0); PG8_SCHED; PG8_LDA(At, 0, 0); PG8_STAGE(PG8_SA(1, 1), a1 + hstep, voffA);
            PG8_WAIT_L(8); PG8_BAR; PG8_WAIT_L(0); PG8_MMA(0, 0, At, B0); PG8_BAR; PG8_SCHED;
            PG8_LDB(B1, 0, 1); PG8_STAGE(PG8_SB(0, 0), b2, voffB);
            PG8_BAR; PG8_WAIT_L(0); PG8_MMA(0, 1, At, B1); PG8_BAR;
            PG8_LDA(At, 0, 1); PG8_STAGE(PG8_SA(0, 0), a2, voffA);
            PG8_BAR; PG8_WAIT_L(0); PG8_MMA(1, 0, At, B0); PG8_BAR; PG8_SCHED;
            PG8_STAGE(PG8_SB(0, 1), b2 + hstep, voffB);
            PG8_WAIT_V(6); PG8_BAR; PG8_MMA(1, 1, At, B1); PG8_BAR;
            PG8_LDB(B0, 1, 0); PG8_SCHED; PG8_LDA(At, 1, 0); PG8_STAGE(PG8_SA(0, 1), a2 + hstep, voffA);
            PG8_WAIT_L(8); PG8_BAR; PG8_WAIT_L(0); PG8_MMA(0, 0, At, B0); PG8_BAR; PG8_SCHED;
            PG8_LDB(B1, 1, 1); PG8_STAGE(PG8_SB(1, 0), b3, voffB);
            PG8_BAR; PG8_WAIT_L(0); PG8_MMA(0, 1, At, B1); PG8_BAR;
            PG8_LDA(At, 1, 1); PG8_STAGE(PG8_SA(1, 0), a3, voffA);
            PG8_BAR; PG8_WAIT_L(0); PG8_MMA(1, 0, At, B0); PG8_BAR; PG8_SCHED;
            PG8_STAGE(PG8_SB(1, 1), b3 + hstep, voffB);
            PG8_WAIT_V(6); PG8_BAR; PG8_MMA(1, 1, At, B1); PG8_BAR;
            }
        }
        if constexpr (F8) asm volatile("s_nop 15\n\ts_nop 15" ::: "memory");
        if constexpr (ALIGN_EPI) { if (wr == 0) PG8_BAR; }
        if constexpr (!Epi::AFTER_DRAIN) { E(acc, cur, wr, wc, fr, fq);
#ifdef PROBE_EPI2
            if constexpr (Epi::PROBE_TWICE) { asm volatile("" ::: "memory"); E(acc, cur, wr, wc, fr, fq); }
#endif
            S.done(cur); }
        if (!has_next) break;
#pragma unroll
        for (int a = 0; a < 2; ++a)
#pragma unroll
            for (int b = 0; b < 2; ++b)
#pragma unroll
                for (int m = 0; m < 4; ++m)
#pragma unroll
                    for (int n = 0; n < 2; ++n) acc[a][b][m][n] = (f32x4){0.f, 0.f, 0.f, 0.f};
        cur = nxt; cA = nA; cB = nB; ++ui;
        if constexpr (ALIGN_EPI) { if (wr == 1) PG8_BAR; }
    }
    PG8_WAIT_V(0);
    if constexpr (!ALIGN_EPI) { if (wr == 0) PG8_BAR; }
    PG8_BAR;
    if constexpr (Epi::AFTER_DRAIN) { E.fused(acc, cur, wr, wc, fr, fq, lds, wid, lane); S.done(cur); }
#undef PG8_SA
#undef PG8_SB
#undef PG8_STAGE
#undef PG8_LDA
#undef PG8_LDB
#undef PG8_MMA
#undef PG8_CAT
#undef PG8_WAIT_V
#undef PG8_WAIT_L
#undef PG8_BAR
#undef PG8_SCHED
}
}
typedef float f32x2 __attribute__((ext_vector_type(2)));
constexpr int NWAVES = 8;
constexpr int BATCH = 8, SEQ = 2048, M = BATCH * SEQ, D = 4096, FF = 11008, NUP = 2 * FF, NIN = 11264, NIN_SRC = 11272, DEPTH = 2;
constexpr int DL = 1024, DFX = 1024, DDL = 2048, NFX = 8, NDL = 16, HD = 128;
constexpr int C_XA = 0, C_GA = 1024, C_QF = 2048, C_KF = 3072, C_VF = 4096, C_QD = 5120, C_KD = 7168, C_VD = 9216;
constexpr int SRC_FF_COL = 5120;
constexpr float EPS = 1e-6f;
#ifndef I8_UP_MASK
#define I8_UP_MASK 0xF
#endif
#ifndef FP8_UP_MASK
#define FP8_UP_MASK 0x0
#endif
#ifndef FP8_DOWN_MASK
#define FP8_DOWN_MASK 0xE
#endif
constexpr float FP8_WMUL = 64.0f, FP8_WMUL_DOWN = 128.0f, FP8_ACT_MUL = 8.0f;
constexpr float ATT_SCALE = 0.08838834764831845f;

constexpr size_t MiB = 1u << 20;
constexpr size_t WS_CTL = 0, CTL_ZERO_BYTES = 1024 * 1024;
constexpr size_t WS_WMAX = 256 * 1024;
constexpr size_t WS_ROPE = 1 * MiB;
constexpr size_t WS_WFF = WS_ROPE + 256 * 1024;
constexpr size_t WS_WG = WS_ROPE + 512 * 1024;
constexpr size_t WS_LF = 3 * MiB;
constexpr size_t WS_SSQ = WS_LF + 512 * 1024;
constexpr size_t WS_W1T = 5 * MiB;
constexpr size_t WS_W2T = WS_W1T + (size_t)4 * NUP * D * 2;
constexpr size_t WS_WIN = WS_W2T + (size_t)4 * D * FF * 2;
constexpr size_t WS_WOUT = WS_WIN + (size_t)2 * NIN * D * 2;
constexpr size_t WS_A1 = WS_WOUT + (size_t)2 * D * D * 2;
constexpr size_t WS_R = WS_A1 + (size_t)M * D * 2;
constexpr size_t WS_ACT = WS_R;
constexpr size_t WS_PROJ = WS_R;
constexpr size_t WS_HL = WS_PROJ + (size_t)M * NIN * 2;
constexpr size_t WS_PP = WS_HL + (size_t)M * DL * 4;
constexpr size_t WS_YB = WS_PP + (size_t)M * DL * 4;
constexpr size_t WS_YCP = WS_YB + (size_t)M * DFX * 2;
constexpr size_t WS_LSE = WS_YCP + (size_t)3 * M * DDL * 2;
constexpr size_t WS_HB = WS_LSE + (size_t)3 * M * NDL * 4;
constexpr size_t WS_HB8 = WS_HB + (size_t)M * D * 2;
constexpr size_t WS_ASC = WS_HB8 + (size_t)M * D;
constexpr size_t WS_END = WS_ASC + (size_t)M * 4;
static_assert(WS_ACT + (size_t)M * FF * 2 <= WS_END && WS_SSQ + (size_t)7 * M * 8 <= WS_W1T && WS_WG + 1024 * 1024 <= WS_LF, "d_ws map");
constexpr int CW_TMO = 0, CW_CODE = 1;
constexpr int CW_BAR = 4096;
constexpr int MAX_LAUNCHES = 8;

constexpr int RING_OFF = 0, RING_BYTES = 131072;
constexpr int LDSCTL_OFF = RING_BYTES, MISC_OFF = LDSCTL_OFF + 320;
constexpr int QS_OFF = RING_BYTES + 1024;
constexpr int LDS_BYTES = 147456;
static_assert(MISC_OFF + 128 <= QS_OFF && QS_OFF + 8192 <= LDS_BYTES, "LDS map");

#define GAS __attribute__((address_space(1)))
#define LAS __attribute__((address_space(3)))
typedef unsigned short bf16;
typedef unsigned v4u __attribute__((ext_vector_type(4)));
typedef float f32x4 __attribute__((ext_vector_type(4)));
typedef short bf16x8 __attribute__((ext_vector_type(8)));
typedef GAS unsigned gu32;
typedef GAS unsigned long long gu64;
#define RLX_AGENT __ATOMIC_RELAXED, __HIP_MEMORY_SCOPE_AGENT
#define LDS_WAIT() asm volatile("s_waitcnt lgkmcnt(0)" ::: "memory")
#define VM_WAIT() asm volatile("s_waitcnt vmcnt(0)" ::: "memory")
__device__ __forceinline__ unsigned long long rt() { return __builtin_amdgcn_s_memrealtime(); }
__device__ __forceinline__ unsigned f2bf(float f) { unsigned u = __builtin_bit_cast(unsigned, f); return (u + 0x7fffu + ((u >> 16) & 1u)) >> 16; }
__device__ __forceinline__ unsigned pk2(float lo, float hi) { return f2bf(lo) | (f2bf(hi) << 16); }

#define XB_TMO      128
#define XB_XCNT(j)  (256  + 64 * (j))
#define XB_XSUB(j)  (1280 + 64 * (j))
#define XB_XGEN(j)  (2304 + 64 * (j))
#define XB_TOP      3328
#define XB_TOPGEN   3392
#define XCD_BAR_WORDS 3456
#define XB_SPIN_CAP (1u << 18)

__device__ __forceinline__ unsigned xb_ld(unsigned* p)              { return __hip_atomic_load(p, __ATOMIC_RELAXED, __HIP_MEMORY_SCOPE_AGENT); }
__device__ __forceinline__ unsigned xb_add(unsigned* p, unsigned v) { return __hip_atomic_fetch_add(p, v, __ATOMIC_RELAXED, __HIP_MEMORY_SCOPE_AGENT); }
__device__ __forceinline__ unsigned xb_xcc_id() { return (unsigned)__builtin_amdgcn_s_getreg((3 << 11) | 20) & 0xFu; }
#define XB_SPIN(cond, bar) do { unsigned _sp = 0; while (cond) { __builtin_amdgcn_s_sleep(1); \
    if ((++_sp & 255u) == 0u) { if (xb_ld(&(bar)[XB_TMO])) break; if (_sp > XB_SPIN_CAP) { atomicAdd(&(bar)[XB_TMO], 1u); break; } } } } while (0)

struct XcdBarrier {
    unsigned* bar; unsigned x;
    volatile LAS unsigned* st;
};

__device__ __forceinline__ XcdBarrier xcd_barrier_post(unsigned* bar, volatile LAS unsigned* st) {
    XcdBarrier b; b.bar = bar; b.x = xb_xcc_id(); b.st = st;
    if (threadIdx.x == 0) (void)xb_add(&bar[XB_XCNT(b.x)], 1u);
    return b;
}
__device__ __forceinline__ void xcd_barrier_complete(unsigned* bar, unsigned x, unsigned& nloc, unsigned& nx) {
    const unsigned G = gridDim.x * gridDim.y * gridDim.z;
    unsigned sum, cnt, mine, sp = 0u;
    for (;;) {
        sum = 0u; cnt = 0u; mine = 0u;
#pragma unroll
        for (unsigned j = 0; j < 16; ++j) { const unsigned c = xb_ld(&bar[XB_XCNT(j)]); sum += c; cnt += (c > 0u) ? 1u : 0u; mine = (j == x) ? c : mine; }
        if (sum == G) break;
        __builtin_amdgcn_s_sleep(1);
        if ((++sp & 255u) == 0u) { if (xb_ld(&bar[XB_TMO])) break; if (sp > XB_SPIN_CAP) { atomicAdd(&bar[XB_TMO], 1u); break; } }
    }
    nloc = mine > 0u ? mine : 1u; nx = cnt > 0u ? cnt : 1u;
}

__device__ __forceinline__ void xcd_barrier(const XcdBarrier& b) {
    asm volatile("s_waitcnt vmcnt(0)" ::: "memory");
    __syncthreads();
    if (threadIdx.x == 0) {
        unsigned* bar = b.bar;
        __builtin_amdgcn_s_waitcnt(0);
        unsigned nloc = b.st[0], nx = b.st[1];
        if (nloc == 0u) { xcd_barrier_complete(bar, b.x, nloc, nx); b.st[0] = nloc; b.st[1] = nx; }
        const unsigned old = xb_add(&bar[XB_XSUB(b.x)], 1u);
        const unsigned gen = old / nloc;
        if (old + 1u == (gen + 1u) * nloc) {
            __builtin_amdgcn_fence(__ATOMIC_RELEASE, "agent");
            asm volatile("s_waitcnt vmcnt(0)" ::: "memory");
            const unsigned og = xb_add(&bar[XB_TOP], 1u);
            const unsigned tg = og / nx;
            if (og + 1u == (tg + 1u) * nx) xb_add(&bar[XB_TOPGEN], 1u);
            else XB_SPIN(xb_ld(&bar[XB_TOPGEN]) == tg, bar);
            __builtin_amdgcn_fence(__ATOMIC_ACQUIRE, "agent");
            xb_add(&bar[XB_XGEN(b.x)], 1u);
            asm volatile("s_waitcnt vmcnt(0)" ::: "memory");
        } else {
            XB_SPIN(xb_ld(&bar[XB_XGEN(b.x)]) == gen, bar);
            __builtin_amdgcn_fence(__ATOMIC_ACQUIRE, "agent");
            asm volatile("s_waitcnt vmcnt(0)" ::: "memory");
        }
    }
    __syncthreads();
}
#ifndef ATT_PRIO1
#define ATT_PRIO1 ((void)0)
#define ATT_PRIO0 ((void)0)
#endif
namespace att {
typedef short bf16x8 __attribute__((ext_vector_type(8)));
typedef short s16x4 __attribute__((ext_vector_type(4)));
typedef float f32x16 __attribute__((ext_vector_type(16)));
typedef float f32x4 __attribute__((ext_vector_type(4)));
typedef unsigned u32x4 __attribute__((ext_vector_type(4)));
constexpr float SCALE = 0.08838834764831845f, THR = 8.f;
constexpr int NW = 8, QBLK = 32, KVBLK = 64, QB = 256, DH = 128;
constexpr int SHM_V = KVBLK * DH * 2, SHM_K = KVBLK * DH * 2;
constexpr int WS_OFF = 2 * SHM_V + 2 * SHM_K, KB_OFF = WS_OFF + NW * 64 * 4, ATT_LDS = KB_OFF + 2048 * 4;
#define KSWZ(row, colB) ((row) * 256 + ((colB) ^ (((row) & 7) << 4)))
#define SBAR() __builtin_amdgcn_sched_barrier(0)
__device__ __forceinline__ int v_st(int k, int c) { const int kk = (k & ~0xC) | ((k & 4) << 1) | ((k & 8) >> 1); return ((kk >> 3) * 4 + (c >> 5)) * 512 + ((kk & 7) * 32 + (c & 31)) * 2; }
__device__ __forceinline__ int v_rd_base(int lane) { return ((lane & 3) << 3) | (((lane >> 2) & 3) << 6) | (((lane >> 4) & 1) << 5) | (((lane >> 5) & 1) << 8); }
constexpr int v_rd_off(int d0, int ks, int half) { return d0 * 512 + ks * 4096 + half * 2048; }
__device__ __forceinline__ int crow(int r, int hi) { return (r & 3) + 8 * (r >> 2) + 4 * hi; }
__device__ __forceinline__ unsigned cvtpk(float lo, float hi) { unsigned r; asm volatile("v_cvt_pk_bf16_f32 %0, %1, %2" : "=v"(r) : "v"(lo), "v"(hi)); return r; }
__device__ __forceinline__ void mask_tile(f32x16& p0, f32x16& p1, int dq, unsigned W) {
    const float NEG = -__builtin_inff();
#pragma unroll
    for (int r = 0; r < 16; ++r) { const int c = (r & 3) + 8 * (r >> 2);
        if ((unsigned)(dq - c) >= W) p0[r] = NEG;
        if ((unsigned)(dq - c - 32) >= W) p1[r] = NEG; }
}
__device__ __forceinline__ void partialSM(f32x16& p0, f32x16& p1, float& m_reg, float& mn, float& alpha) {
    float pmax = p0[0];
#pragma unroll
    for (int r = 1; r < 16; ++r) pmax = fmaxf(pmax, p0[r]);
#pragma unroll
    for (int r = 0; r < 16; ++r) pmax = fmaxf(pmax, p1[r]);
    { auto rr = __builtin_amdgcn_permlane32_swap(__float_as_uint(pmax), __float_as_uint(pmax), false, false);
      pmax = fmaxf(__uint_as_float(rr[0]), __uint_as_float(rr[1])); }
    constexpr float C2 = 1.4426950408889634f * SCALE;
    if (__builtin_expect(__all((pmax - m_reg) * SCALE <= THR), 1)) { mn = m_reg; alpha = 1.f; }
    else { mn = fmaxf(m_reg, pmax); alpha = __builtin_amdgcn_exp2f((m_reg - mn) * C2); m_reg = mn; }
    const float mnL = -mn * C2;
#pragma unroll
    for (int r = 0; r < 16; ++r) p0[r] = fmaf(p0[r], C2, mnL);
#pragma unroll
    for (int r = 0; r < 16; ++r) p1[r] = fmaf(p1[r], C2, mnL);
#pragma unroll
    for (int r = 0; r < 16; ++r) p0[r] = __builtin_amdgcn_exp2f(p0[r]);
}
__device__ __forceinline__ void finishSM(f32x16& p0, f32x16& p1, float alpha, float& l_reg, bf16x8& pa0, bf16x8& pa1, bf16x8& pa2, bf16x8& pa3) {
#pragma unroll
    for (int r = 0; r < 16; ++r) p1[r] = __builtin_amdgcn_exp2f(p1[r]);
    float ps = 0;
#pragma unroll
    for (int r = 0; r < 16; ++r) ps += p0[r];
#pragma unroll
    for (int r = 0; r < 16; ++r) ps += p1[r];
    { auto rr = __builtin_amdgcn_permlane32_swap(__float_as_uint(ps), __float_as_uint(ps), false, false);
      ps = __uint_as_float(rr[0]) + __uint_as_float(rr[1]); }
    l_reg = l_reg * alpha + ps;
#define PK4(P, B_, OUT) do { unsigned a0 = cvtpk(P[B_+0], P[B_+1]), a1 = cvtpk(P[B_+2], P[B_+3]);                          \
        unsigned b0 = cvtpk(P[B_+4], P[B_+5]), b1 = cvtpk(P[B_+6], P[B_+7]);                                             \
        auto r0 = __builtin_amdgcn_permlane32_swap(a0, b0, false, false); auto r1 = __builtin_amdgcn_permlane32_swap(a1, b1, false, false); \
        u32x4 w = {r0[0], r1[0], r0[1], r1[1]}; OUT = *reinterpret_cast<bf16x8*>(&w); } while (0)
    PK4(p0, 0, pa0); PK4(p0, 8, pa1); PK4(p1, 0, pa2); PK4(p1, 8, pa3);
#undef PK4
}
template <int KB>
__device__ __forceinline__ void qkt(f32x16& p0, f32x16& p1, const char* K_lds, int r32, int hi, const bf16x8* qr, bool act) {
    if (!act) { const float NEG = -__builtin_inff();
#pragma unroll
        for (int r = 0; r < 16; ++r) { p0[r] = NEG; p1[r] = NEG; } return; }
    p0 = f32x16{}; p1 = f32x16{};
    const char* kb[4];
#pragma unroll
    for (int dd = 0; dd < 4; ++dd) kb[dd] = K_lds + KB * SHM_K + KSWZ(r32, (dd * 16 + hi * 8) * 2);
    ATT_PRIO1;
#pragma unroll
    for (int d0 = 0; d0 < 8; ++d0) { const char* a = kb[d0 & 3] + (d0 >> 2) * 128;
        bf16x8 b0 = *reinterpret_cast<const bf16x8*>(a);
        bf16x8 b1 = *reinterpret_cast<const bf16x8*>(a + 32 * 256);
        p0 = __builtin_amdgcn_mfma_f32_32x32x16_bf16(b0, qr[d0], p0, 0, 0, 0);
        p1 = __builtin_amdgcn_mfma_f32_32x32x16_bf16(b1, qr[d0], p1, 0, 0, 0); }
    ATT_PRIO0;
}
template <int VB>
__device__ __forceinline__ void pv_tile(f32x16* o, int vb0, bf16x8 pa0, bf16x8 pa1, bf16x8 pa2, bf16x8 pa3, bool act) {
    if (!act) return;
#define TRRD(dst, off) asm volatile("ds_read_b64_tr_b16 %0, %1 offset:%2" : "=&v"(dst) : "v"(vb0), "i"(off) : "memory")
#define PV_D0(d0) do { s16x4 l0, l1, l2, l3, h0, h1, h2, h3; constexpr int b_ = VB * SHM_V + v_rd_off(d0, 0, 0); \
        TRRD(l0, b_); TRRD(h0, b_ + 2048); TRRD(l1, b_ + 4096); TRRD(h1, b_ + 6144); TRRD(l2, b_ + 8192); TRRD(h2, b_ + 10240); TRRD(l3, b_ + 12288); TRRD(h3, b_ + 14336); \
        asm volatile("s_waitcnt lgkmcnt(0)" ::: "memory"); SBAR();   \
        o[d0] = __builtin_amdgcn_mfma_f32_32x32x16_bf16(pa0, (bf16x8){l0[0], l0[1], l0[2], l0[3], h0[0], h0[1], h0[2], h0[3]}, o[d0], 0, 0, 0);   \
        o[d0] = __builtin_amdgcn_mfma_f32_32x32x16_bf16(pa1, (bf16x8){l1[0], l1[1], l1[2], l1[3], h1[0], h1[1], h1[2], h1[3]}, o[d0], 0, 0, 0);   \
        o[d0] = __builtin_amdgcn_mfma_f32_32x32x16_bf16(pa2, (bf16x8){l2[0], l2[1], l2[2], l2[3], h2[0], h2[1], h2[2], h2[3]}, o[d0], 0, 0, 0);   \
        o[d0] = __builtin_amdgcn_mfma_f32_32x32x16_bf16(pa3, (bf16x8){l3[0], l3[1], l3[2], l3[3], h3[0], h3[1], h3[2], h3[3]}, o[d0], 0, 0, 0); } while (0)
    ATT_PRIO1; PV_D0(0); PV_D0(1); PV_D0(2); PV_D0(3); ATT_PRIO0;
#undef PV_D0
#undef TRRD
}
struct Blk {
    const unsigned short* Q; const unsigned short* K; const unsigned short* V; unsigned short* O; float* L;
    int qstride, kstride, ostride, lstride; int pair_off, opair_off, lpair_off;
    int P0, j_lo, NT, W, pair;
    const float* kbias;
};
template <bool BIAS>
__device__ __forceinline__ void attn_block(const Blk& B, char* lds) {
    int tz = threadIdx.x; asm volatile("" : "+v"(tz));
    const int tid = tz, wid = __builtin_amdgcn_readfirstlane(tid >> 6), lane = tid & 63, r32 = lane & 31, hi = lane >> 5;
    const int NT = B.NT, W = B.W, pair = B.pair, j_lo = B.j_lo;
    const int seq = pair ? (wid >> 2) : 0, wq = pair ? (wid & 3) : wid;
    const int qlo = pair ? seq * 1024 + wq * 32 : B.P0 + wid * 32, qm = qlo + r32 - 4 * hi;
    char* V_lds = lds; char* K_lds = lds + 2 * SHM_V;
    float* ws = (float*)(lds + WS_OFF) + wid * 64; float* li_l = ws, * al_l = ws + 32;
    const float* kbl = (const float*)(lds + KB_OFF);
    float m_reg = -1e30f, l_reg = 0; f32x16 o[4] = {};
    const int sr = tid >> 4, sc = (tid & 15) * 8, vst0 = v_st(sr, sc), vst1 = v_st(32 + sr, sc), kws = KSWZ(sr, sc * 2);
    const int vb0 = (int)(uintptr_t)V_lds + v_rd_base(lane);
    const unsigned short* Kh = B.K; const unsigned short* Vh = B.V; const int kstride = B.kstride;
    bf16x8 st_v0, st_v1, st_k0, st_k1;
#define KPOS(t) (pair ? ((t) >> 1) * 1024 + ((t) & 1) * 64 : (j_lo + (t)) * 64)
#define KOFF(t) (pair ? (size_t)((t) >> 1) * B.pair_off + (size_t)(((t) & 1) * 64) * kstride : (size_t)((j_lo + (t)) * 64) * kstride)
#define SLOAD_H(t) do { const size_t ko_ = KOFF(t) + (size_t)sr * kstride + sc; const size_t k32_ = (size_t)32 * kstride; \
        st_v0 = *(const bf16x8*)(Vh + ko_); st_v1 = *(const bf16x8*)(Vh + ko_ + k32_); st_k0 = *(const bf16x8*)(Kh + ko_); st_k1 = *(const bf16x8*)(Kh + ko_ + k32_); } while (0)
#define SWRITE_H(bf) do { *(bf16x8*)(V_lds + (bf) * SHM_V + vst0) = st_v0; *(bf16x8*)(V_lds + (bf) * SHM_V + vst1) = st_v1; \
        *(bf16x8*)(K_lds + (bf) * SHM_K + kws) = st_k0; *(bf16x8*)(K_lds + (bf) * SHM_K + kws + 32 * 256) = st_k1; } while (0)
#define VMW() asm volatile("s_waitcnt vmcnt(0)" ::: "memory")
#define RESC(a) do { if (__any((a) < 1.f)) { if (hi == 0) al_l[r32] = (a); asm volatile("s_waitcnt lgkmcnt(0)" ::: "memory");              \
                     for (int d_ = 0; d_ < 4; ++d_) for (int r = 0; r < 16; ++r) o[d_][r] *= al_l[crow(r, hi)]; } } while (0)
#define ACT(t) (KPOS(t) <= qlo + QBLK - 1 && KPOS(t) + KVBLK - 1 >= qlo - W + 1)
#define MASKT(P0_, P1_, t) do { const int kb_ = KPOS(t); if (ACT(t)) { \
        if (BIAS) { const float* bp_ = kbl + kb_ + 4 * hi; _Pragma("unroll") for (int g_ = 0; g_ < 4; ++g_) { const f32x4 b0_ = *(const f32x4*)(bp_ + 8 * g_), b1_ = *(const f32x4*)(bp_ + 32 + 8 * g_); \
            _Pragma("unroll") for (int j_ = 0; j_ < 4; ++j_) { P0_[4 * g_ + j_] += b0_[j_]; P1_[4 * g_ + j_] += b1_[j_]; } } } \
        if (kb_ + KVBLK - 1 > qlo || kb_ <= qlo + QBLK - 1 - W) mask_tile(P0_, P1_, qm - kb_, (unsigned)W); } } while (0)
    bf16x8 qr[8];
    { const unsigned short* qrow = B.Q + (size_t)seq * B.pair_off + (size_t)(wq * 32 + r32) * B.qstride;
#pragma unroll
      for (int d0 = 0; d0 < 8; ++d0) qr[d0] = *(const bf16x8*)(qrow + d0 * 16 + hi * 8); }
    f32x16 pA0, pA1, pB0, pB1; float mnA, mnB, alA, alB; bf16x8 pa0, pa1, pa2, pa3;
    SLOAD_H(0); VMW(); SWRITE_H(0); SBAR();
    if (NT > 1) SLOAD_H(1);
    __syncthreads();
    SBAR(); qkt<0>(pA0, pA1, K_lds, r32, hi, qr, ACT(0));
    MASKT(pA0, pA1, 0); partialSM(pA0, pA1, m_reg, mnA, alA);
    if (NT > 1) { VMW(); SWRITE_H(1); }
    __syncthreads();
#define HALF_STEP(PX0, PX1, mnX, alX, PY0, PY1, alY, t, KB, VB, SB) do {                                                      \
        SBAR(); qkt<KB>(PX0, PX1, K_lds, r32, hi, qr, ACT(t));                                                                \
        finishSM(PY0, PY1, alY, l_reg, pa0, pa1, pa2, pa3); SBAR();                                                           \
        if ((t) + 1 < NT) { SLOAD_H((t) + 1); SBAR(); }                                                                       \
        pv_tile<VB>(o, vb0, pa0, pa1, pa2, pa3, ACT((t) - 1)); MASKT(PX0, PX1, (t)); partialSM(PX0, PX1, m_reg, mnX, alX);    \
        __syncthreads();                                                                                                      \
        if ((t) + 1 < NT) { VMW(); SWRITE_H(SB); }                                                                            \
        RESC(alX); __syncthreads(); } while (0)
    for (int t = 1; t + 1 < NT; t += 2) {
        HALF_STEP(pB0, pB1, mnB, alB, pA0, pA1, alA, t, 1, 0, 0);
        HALF_STEP(pA0, pA1, mnA, alA, pB0, pB1, alB, t + 1, 0, 1, 1);
    }
    const bool even = (NT & 1) == 0;
    if (even) { SBAR(); qkt<1>(pB0, pB1, K_lds, r32, hi, qr, ACT(NT - 1)); SBAR(); }
    finishSM(pA0, pA1, alA, l_reg, pa0, pa1, pa2, pa3); SBAR();
    pv_tile<0>(o, vb0, pa0, pa1, pa2, pa3, ACT(even ? NT - 2 : NT - 1));
    if (even) { MASKT(pB0, pB1, NT - 1); partialSM(pB0, pB1, m_reg, mnB, alB); __syncthreads(); RESC(alB);
        finishSM(pB0, pB1, alB, l_reg, pa0, pa1, pa2, pa3); SBAR(); pv_tile<1>(o, vb0, pa0, pa1, pa2, pa3, ACT(NT - 1)); }
    SBAR();
    if (hi == 0) li_l[r32] = l_reg; asm volatile("s_waitcnt lgkmcnt(0)" ::: "memory");
    float rli[16];
#pragma unroll
    for (int r = 0; r < 16; ++r) rli[r] = __builtin_amdgcn_rcpf(li_l[crow(r, hi)]);
    unsigned short* Ow = B.O + (size_t)seq * B.opair_off + (size_t)(wq * 32) * B.ostride;
#pragma unroll
    for (int r = 0; r < 16; ++r) { const int orow = crow(r, hi);
#pragma unroll
        for (int d0 = 0; d0 < 4; ++d0) { const float v = o[d0][r] * rli[r]; const float vn = __shfl_xor(v, 1);
            if ((r32 & 1) == 0) *(unsigned*)(Ow + (size_t)orow * B.ostride + d0 * 32 + r32) = cvtpk(v, vn); } }
    if (B.L != nullptr && hi == 0) B.L[(size_t)seq * B.lpair_off + (size_t)(wq * 32 + r32) * B.lstride] = m_reg * SCALE + __logf(l_reg);
    __syncthreads();
#undef KPOS
#undef KOFF
#undef SLOAD_H
#undef SWRITE_H
#undef VMW
#undef RESC
#undef ACT
#undef MASKT
#undef HALF_STEP
}
#undef KSWZ
#undef SBAR
}
static_assert((CW_BAR + MAX_LAUNCHES * XCD_BAR_WORDS) * 4 <= (int)CTL_ZERO_BYTES, "CTL words inside the memset region");

struct Frame {
    LAS unsigned char* lds;
    int tid, lane, wave;
    int vcu, G, bx;
};
__device__ __forceinline__ float wave_sum(float v) {
#pragma unroll
    for (int o = 1; o < 64; o <<= 1) v += __shfl_xor(v, o);
    return v;
}
__device__ __forceinline__ float wave_max(float v) {
#pragma unroll
    for (int o = 1; o < 64; o <<= 1) v = fmaxf(v, __shfl_xor(v, o));
    return v;
}
__device__ __forceinline__ float bf_lo(unsigned w) { return __builtin_bit_cast(float, w << 16); }
__device__ __forceinline__ float bf_hi(unsigned w) { return __builtin_bit_cast(float, w & 0xffff0000u); }
__device__ __forceinline__ float bf2f(bf16 b) { return __builtin_bit_cast(float, (unsigned)b << 16); }

__device__ __forceinline__ void transpose64(const float* __restrict__ W, int ldw, int src_col0, int k0, bf16* __restrict__ WT, int K, int dest_row0, LAS unsigned* scr, int lane, const float* __restrict__ kscale = nullptr, int tm_nt = 0) {
    const int q = lane & 15, r = lane >> 4;
#pragma unroll
    for (int p = 0; p < 8; ++p) { const int kr = 8 * p + 2 * r;
        f32x4 a = *(const f32x4*)(W + (size_t)(k0 + kr) * ldw + src_col0 + 4 * q);
        f32x4 b = *(const f32x4*)(W + (size_t)(k0 + kr + 1) * ldw + src_col0 + 4 * q);
        if (kscale != nullptr) { a = a * kscale[k0 + kr]; b = b * kscale[k0 + kr + 1]; }
        const int kp = 4 * p + r;
#pragma unroll
        for (int j = 0; j < 4; ++j) { unsigned w_ = pg8::cvt_pk_bf16(a[j], b[j]);
#ifdef PROBE_WTRUNC
            w_ = (w_ + PROBE_WTRUNC_ADD) & PROBE_WTRUNC_MASK;
#endif
            scr[(4 * q + j) * 33 + kp] = w_; } }
    LDS_WAIT(); asm volatile("" ::: "memory");
    const int c = lane & 7;
#pragma unroll
    for (int jj = 0; jj < 8; ++jj) { const int n = (lane >> 3) + 8 * jj; const LAS unsigned* s = scr + n * 33 + 4 * c;
        v4u o; o.x = s[0]; o.y = s[1]; o.z = s[2]; o.w = s[3];
        const int dn_ = dest_row0 + n;
        if (tm_nt) *(v4u*)((unsigned char*)WT + ((size_t)((dn_ >> 8) * tm_nt + (k0 >> 6)) * 256 + (dn_ & 255)) * 128 + 16 * c) = o;
        else *(v4u*)(WT + (size_t)dn_ * K + k0 + 8 * c) = o; }
    LDS_WAIT(); asm volatile("" ::: "memory");
}
struct Args { const float* in[22]; float* out; unsigned char* ws; int ph_lo, ph_hi, li, pad; };
__device__ __forceinline__ void transpose64_fp8(const float* __restrict__ W, int ldw, int src_col0, int k0, unsigned char* __restrict__ WT, int K, int dest_row0, LAS unsigned* scr, int lane, const float* __restrict__ kscale, float wmul, int tm_nt = 0) {
    const int q = lane & 15, r = lane >> 4;
#pragma unroll
    for (int p = 0; p < 4; ++p) { const int kr = 16 * p + 4 * r;
        f32x4 a[4];
#pragma unroll
        for (int i = 0; i < 4; ++i) { a[i] = *(const f32x4*)(W + (size_t)(k0 + kr + i) * ldw + src_col0 + 4 * q); a[i] = a[i] * ((kscale != nullptr ? kscale[k0 + kr + i] : 1.0f) * wmul); }
#pragma unroll
        for (int j = 0; j < 4; ++j) { int w_ = 0; w_ = __builtin_amdgcn_cvt_pk_fp8_f32(a[0][j], a[1][j], w_, false); w_ = __builtin_amdgcn_cvt_pk_fp8_f32(a[2][j], a[3][j], w_, true);
            scr[(4 * q + j) * 17 + 4 * p + r] = (unsigned)w_; } }
    LDS_WAIT(); asm volatile("" ::: "memory");
    const int c = lane & 3;
#pragma unroll
    for (int jj = 0; jj < 4; ++jj) { const int n = (lane >> 2) + 16 * jj; const LAS unsigned* s = scr + n * 17 + 4 * c;
        v4u o; o.x = s[0]; o.y = s[1]; o.z = s[2]; o.w = s[3];
        const int dn_ = dest_row0 + n;
        if (tm_nt) *(v4u*)(WT + ((size_t)((dn_ >> 8) * tm_nt + (k0 >> 7)) * 256 + (dn_ & 255)) * 128 + (k0 & 127) + 16 * c) = o;
        else *(v4u*)(WT + (size_t)dn_ * K + k0 + 16 * c) = o; }
    LDS_WAIT(); asm volatile("" ::: "memory");
}
__device__ __forceinline__ void transpose64_i8(const float* __restrict__ W, int ldw, int src_col0, int k0, unsigned char* __restrict__ WT, int K, int dest_row0, LAS unsigned* scr, int lane, const float* __restrict__ kscale, const unsigned* __restrict__ cmax, int tm_nt = 0) {
    const int q = lane & 15, r = lane >> 4;
    f32x4 inv;
    { const v4u mx = *(const v4u*)(cmax + dest_row0 + 4 * q);
#pragma unroll
      for (int j = 0; j < 4; ++j) inv[j] = 127.0f / fmaxf(__uint_as_float(mx[j]), 1e-30f); }
#pragma unroll
    for (int p = 0; p < 4; ++p) { const int kr = 16 * p + 4 * r;
        f32x4 a[4];
#pragma unroll
        for (int i = 0; i < 4; ++i) { a[i] = *(const f32x4*)(W + (size_t)(k0 + kr + i) * ldw + src_col0 + 4 * q); a[i] = a[i] * (kscale != nullptr ? kscale[k0 + kr + i] : 1.0f) * inv; }
#pragma unroll
        for (int j = 0; j < 4; ++j) { unsigned w_ = 0u;
#pragma unroll
            for (int i = 0; i < 4; ++i) { int qv = __float2int_rn(a[i][j]); qv = qv < -127 ? -127 : (qv > 127 ? 127 : qv); w_ |= ((unsigned)qv & 0xffu) << (8 * i); }
            scr[(4 * q + j) * 17 + 4 * p + r] = w_; } }
    LDS_WAIT(); asm volatile("" ::: "memory");
    const int c = lane & 3;
#pragma unroll
    for (int jj = 0; jj < 4; ++jj) { const int n = (lane >> 2) + 16 * jj; const LAS unsigned* s = scr + n * 17 + 4 * c;
        v4u o; o.x = s[0]; o.y = s[1]; o.z = s[2]; o.w = s[3];
        const int dn_ = dest_row0 + n;
        if (tm_nt) *(v4u*)(WT + ((size_t)((dn_ >> 8) * tm_nt + (k0 >> 7)) * 256 + (dn_ & 255)) * 128 + (k0 & 127) + 16 * c) = o;
        else *(v4u*)(WT + (size_t)dn_ * K + k0 + 16 * c) = o; }
    LDS_WAIT(); asm volatile("" ::: "memory");
}
__device__ __forceinline__ void colmax_job(const Frame& F, const float* __restrict__ W, int ldw, int K, int Nsrc, const float* __restrict__ kscale, unsigned* __restrict__ cmax) {
    const int gw = F.vcu * NWAVES + F.wave, NGW = F.G * NWAVES;
    const int ncg = Nsrc / 256, nkc = K / 128, ntasks = ncg * nkc;
    for (int t = gw; t < ntasks; t += NGW) { const int kc = t / ncg, cg = t - kc * ncg, c = cg * 256 + 4 * F.lane;
        f32x4 mx = {0.f, 0.f, 0.f, 0.f}; const float* wp = W + (size_t)(kc * 128) * ldw + c; const float* ks = kscale + kc * 128;
#pragma unroll 16
        for (int k = 0; k < 128; ++k) { const f32x4 v = *(const f32x4*)(wp + (size_t)k * ldw) * ks[k];
            mx.x = fmaxf(mx.x, fabsf(v.x)); mx.y = fmaxf(mx.y, fabsf(v.y)); mx.z = fmaxf(mx.z, fabsf(v.z)); mx.w = fmaxf(mx.w, fabsf(v.w)); }
        const int half = c >= FF ? 1 : 0, cc = c - half * FF, dest = (cc >> 7) * 256 + half * 128 + (cc & 127);
#pragma unroll
        for (int j = 0; j < 4; ++j) atomicMax(cmax + dest + j, __float_as_uint(mx[j])); }
}
__device__ __forceinline__ void transpose_job(const Frame& F, const float* W, int ldw, int K, int Ndest, bf16* WT, int kind, const float* kscale = nullptr, int gw_ = -1, int ngw_ = 0, float f8mul = 0.f, const unsigned* cmax = nullptr, int it_lo = 0, int it_hi = -1, int tm = 0, int rev = 0) {
    LAS unsigned* scr = (LAS unsigned*)(F.lds + RING_OFF) + F.wave * (64 * 33);
    const int gw = gw_ >= 0 ? gw_ : F.vcu * NWAVES + F.wave, NGW = gw_ >= 0 ? ngw_ : F.G * NWAVES;
    const int nnb = Ndest / 64, nitems = (K / 64) * nnb;
    const int it_end = it_hi < 0 ? nitems : it_hi;
    for (int it0 = it_lo + gw; it0 < it_end; it0 += NGW) { const int it = rev ? it_lo + it_end - 1 - it0 : it0;
        const int kb = it / nnb, nb = it - kb * nnb, n0 = nb * 64;
        int src;
        if (kind == 0) { const int pn = n0 >> 8, within = n0 & 255; src = (within >> 7) * FF + pn * 128 + (within & 127); }
        else if (kind == 2) src = n0 < SRC_FF_COL ? n0 : n0 + 8;
        else src = n0;
        if (cmax != nullptr) transpose64_i8(W, ldw, src, kb * 64, (unsigned char*)WT, K, n0, scr, F.lane, kscale, cmax, tm ? K / 128 : 0);
        else if (f8mul != 0.f) transpose64_fp8(W, ldw, src, kb * 64, (unsigned char*)WT, K, n0, scr, F.lane, kscale, f8mul, tm ? K / 128 : 0);
        else transpose64(W, ldw, src, kb * 64, WT, K, n0, scr, F.lane, kscale, tm ? K / 64 : 0);
    }
}
__device__ __forceinline__ void p0_prologue(const Frame& F, const Args& P) {
    unsigned char* ws = P.ws;
    for (int fi = 0; fi < 4; ++fi) { const int l = fi >> 1, wh = fi & 1;
        if (!((I8_UP_MASK >> fi) & 1)) transpose_job(F, P.in[wh ? 19 : 2] + (size_t)l * D * NUP, NUP, D, NUP, (bf16*)(ws + WS_W1T) + (size_t)fi * NUP * D, 0, P.in[wh ? 18 : 1] + (size_t)l * D, -1, 0, ((FP8_UP_MASK >> fi) & 1) ? FP8_WMUL : 0.f,
                      ((I8_UP_MASK >> fi) & 1) ? (const unsigned*)(ws + WS_WMAX) + (size_t)fi * NUP : nullptr, 0, -1, ((I8_UP_MASK >> fi) & 1) ? 1 : 0);
          }
    for (int l = 0; l < DEPTH; ++l) {
        transpose_job(F, P.in[5] + (size_t)l * D * NIN_SRC, NIN_SRC, D, NIN, (bf16*)(ws + WS_WIN) + (size_t)l * NIN * D, 2, P.in[4] + (size_t)l * D);
        transpose_job(F, P.in[17] + (size_t)l * D * D, D, D, D, (bf16*)(ws + WS_WOUT) + (size_t)l * D * D, 1); }
    { LAS unsigned* scr = (LAS unsigned*)(F.lds + RING_OFF) + F.wave * (64 * 33); const int gw = F.vcu * NWAVES + F.wave, NGW = F.G * NWAVES;
      for (int it = gw; it < DEPTH * 2 * 8 * 4; it += NGW) { const int q = it & 3, mat = it >> 2, gg = mat & 7, gate = (mat >> 3) & 1, l = mat >> 4;
          const float* W = P.in[gate ? 10 : 8] + ((size_t)l * 8 + gg) * 128 * 128;
          transpose64(W, 128, (q & 1) * 64, (q >> 1) * 64, (bf16*)(ws + WS_WG) + (((size_t)l * 2 + gate) * 8 + gg) * 128 * 128, 128, (q & 1) * 64, scr, F.lane); } }
    const int gt = F.bx * (NWAVES * 64) + F.tid, NGT = F.G * NWAVES * 64;
    float* wff = (float*)(ws + WS_WFF);
    for (int i = gt; i < DEPTH * 8 * D; i += NGT) { const int l = i / (8 * D), j = (i / D) & 7, k = i % D;
        wff[i] = P.in[5][(size_t)l * D * NIN_SRC + (size_t)k * NIN_SRC + SRC_FF_COL + j] * P.in[4][(size_t)l * D + k]; }
    float* rc = (float*)(ws + WS_ROPE); float* rs = rc + SEQ * 16;
    for (int i = gt; i < SEQ * 16; i += NGT) { const int pos = i >> 4, fi = i & 15;
        const float inv = 1.0f / powf(500000.0f, (float)(2 * fi) / 32.0f); const float ang = (float)pos * inv;
        rc[i] = cosf(ang); rs[i] = sinf(ang); }
    unsigned long long* ssq = (unsigned long long*)(ws + WS_SSQ);
    for (int i = gt; i < 6 * M; i += NGT) ssq[M + i] = 0ull;
    { bf16* hb = (bf16*)(ws + WS_HB); const float* x = P.in[0]; const int gw = F.vcu * NWAVES + F.wave, NGW = F.G * NWAVES;
      unsigned char* hq = ws + WS_HB8; float* asc = (float*)(ws + WS_ASC);
      for (int row = gw; row < M; row += NGW) { const f32x4* xr = (const f32x4*)(x + (size_t)row * D) + F.lane; unsigned long long* o8 = (unsigned long long*)(hb + (size_t)row * D) + F.lane; float ss = 0.f, mx = 0.f;
          f32x4 r[16];
#pragma unroll
          for (int j = 0; j < 16; ++j) { const f32x4 v = xr[64 * j]; const unsigned w0 = pg8::cvt_pk_bf16(v.x, v.y), w1 = pg8::cvt_pk_bf16(v.z, v.w); o8[64 * j] = (unsigned long long)w0 | ((unsigned long long)w1 << 32);
              const float a = bf_lo(w0), b = bf_hi(w0), c = bf_lo(w1), d = bf_hi(w1); ss += (a * a + b * b) + (c * c + d * d); r[j] = (f32x4){a, b, c, d};
              mx = fmaxf(fmaxf(mx, fmaxf(fabsf(a), fabsf(b))), fmaxf(fabsf(c), fabsf(d))); }
          ss = wave_sum(ss); if (F.lane == 0) ssq[row] = (unsigned long long)(ss * 1048576.0f + 0.5f);
          if (I8_UP_MASK & 1) { mx = fmaxf(wave_max(mx), 1e-30f); const float inv = 127.0f / mx; unsigned char* qp = hq + ((size_t)(row >> 8) * (D / 128) * 256 + (row & 255)) * 128 + (size_t)(F.lane >> 5) * 32768 + ((4 * F.lane) & 127);
#pragma unroll
              for (int j = 0; j < 16; ++j) { unsigned w_ = 0u;
#pragma unroll
                  for (int e = 0; e < 4; ++e) { int qv = __float2int_rn(r[j][e] * inv); qv = qv < -127 ? -127 : (qv > 127 ? 127 : qv); w_ |= ((unsigned)qv & 0xffu) << (8 * e); }
                  *(unsigned*)(qp + (size_t)j * 65536) = w_; }
              if (F.lane == 0) asc[row] = mx * (1.0f / 127.0f); } } }
}

__device__ __forceinline__ void ff_rows(const Frame& F, const bf16* __restrict__ hb, const unsigned long long* __restrict__ ssq, const float* __restrict__ wff, const float* __restrict__ bff, float* __restrict__ lf) {
    LAS float* wl = (LAS float*)(F.lds + RING_OFF);
    for (int i = F.tid; i < 8 * D / 4; i += NWAVES * 64) ((LAS f32x4*)wl)[i] = ((const f32x4*)wff)[i];
    __syncthreads();
    const int gw = F.vcu * NWAVES + F.wave, NGW = F.G * NWAVES;
    for (int row = gw; row < M; row += 2 * NGW) {
        const int row1 = row + NGW < M ? row + NGW : row;
        const uint2* hr0 = (const uint2*)(hb + (size_t)row * D) + F.lane; const uint2* hr1 = (const uint2*)(hb + (size_t)row1 * D) + F.lane;
        uint2 w0[16], w1[16];
#pragma unroll
        for (int j = 0; j < 16; ++j) { w0[j] = hr0[64 * j]; w1[j] = hr1[64 * j]; }
        const float rstd0 = 1.0f / sqrtf((float)ssq[row] * (1.0f / (1048576.0f * D)) + EPS), rstd1 = 1.0f / sqrtf((float)ssq[row1] * (1.0f / (1048576.0f * D)) + EPS);
        float mine0 = 0.f, mine1 = 0.f;
#pragma unroll 1
        for (int h = 0; h < 8; ++h) { float a0 = 0.f, a1 = 0.f;
#pragma unroll
            for (int j = 0; j < 16; ++j) { const f32x4 w = ((const LAS f32x4*)(wl + h * D))[F.lane + 64 * j];
                a0 += (bf_lo(w0[j].x) * w.x + bf_hi(w0[j].x) * w.y) + (bf_lo(w0[j].y) * w.z + bf_hi(w0[j].y) * w.w);
                a1 += (bf_lo(w1[j].x) * w.x + bf_hi(w1[j].x) * w.y) + (bf_lo(w1[j].y) * w.z + bf_hi(w1[j].y) * w.w); }
            a0 = wave_sum(a0); a1 = wave_sum(a1); mine0 = (F.lane == h) ? a0 : mine0; mine1 = (F.lane == h) ? a1 : mine1; }
        if (F.lane < 8) { const float z0 = mine0 * rstd0 + bff[F.lane]; lf[(size_t)row * 8 + F.lane] = fminf(z0, 0.f) - __logf(1.0f + __expf(-fabsf(z0)));
            const float z1 = mine1 * rstd1 + bff[F.lane]; lf[(size_t)row1 * 8 + F.lane] = fminf(z1, 0.f) - __logf(1.0f + __expf(-fabsf(z1))); }
    }
    __syncthreads();
}
__device__ __forceinline__ void final_rows(const Frame& F, const bf16* __restrict__ hb, const unsigned long long* __restrict__ ssq, const float* __restrict__ gain, float* __restrict__ out) {
    const int gw = F.vcu * NWAVES + F.wave, NGW = F.G * NWAVES;
    for (int row = gw; row < M; row += NGW) {
        const uint2* hr = (const uint2*)(hb + (size_t)row * D) + F.lane; f32x4* orow = (f32x4*)(out + (size_t)row * D) + F.lane; const f32x4* gr = (const f32x4*)gain + F.lane;
        const float rstd = 1.0f / sqrtf((float)ssq[row] * (1.0f / (1048576.0f * D)) + EPS);
#pragma unroll
        for (int j = 0; j < 16; ++j) { const uint2 w = hr[64 * j]; orow[64 * j] = (f32x4){bf_lo(w.x), bf_hi(w.x), bf_lo(w.y), bf_hi(w.y)} * rstd * gr[64 * j]; }
    }
}

__device__ __forceinline__ void p00_colmax(const Frame& F, const Args& P) {
    for (int fi = 0; fi < 4; ++fi) if ((I8_UP_MASK >> fi) & 1) { const int l = fi >> 1, wh = fi & 1;
        colmax_job(F, P.in[wh ? 19 : 2] + (size_t)l * D * NUP, NUP, D, NUP, P.in[wh ? 18 : 1] + (size_t)l * D, (unsigned*)(P.ws + WS_WMAX) + (size_t)fi * NUP); }
}
__device__ __forceinline__ void quant_rows(const Frame& F, const bf16* __restrict__ hb, unsigned char* __restrict__ hq, float* __restrict__ asc) {
    const int gw = F.vcu * NWAVES + F.wave, NGW = F.G * NWAVES;
    for (int row = gw; row < M; row += NGW) {
        const uint2* hr = (const uint2*)(hb + (size_t)row * D) + F.lane;
        f32x4 v[16]; float mx = 0.f;
#pragma unroll
        for (int j = 0; j < 16; ++j) { const uint2 w = hr[64 * j]; v[j] = (f32x4){bf_lo(w.x), bf_hi(w.x), bf_lo(w.y), bf_hi(w.y)};
            mx = fmaxf(fmaxf(mx, fmaxf(fabsf(v[j].x), fabsf(v[j].y))), fmaxf(fabsf(v[j].z), fabsf(v[j].w))); }
        mx = fmaxf(wave_max(mx), 1e-30f);
        const float inv = 127.0f / mx;
        unsigned char* qp = hq + ((size_t)(row >> 8) * (D / 128) * 256 + (row & 255)) * 128 + (size_t)(F.lane >> 5) * 32768 + ((4 * F.lane) & 127);
#pragma unroll
        for (int j = 0; j < 16; ++j) { unsigned w_ = 0u;
#pragma unroll
            for (int e = 0; e < 4; ++e) { int qv = __float2int_rn(v[j][e] * inv); qv = qv < -127 ? -127 : (qv > 127 ? 127 : qv); w_ |= ((unsigned)qv & 0xffu) << (8 * e); }
            *(unsigned*)(qp + (size_t)j * 65536) = w_; }
        if (F.lane == 0) asc[row] = mx * (1.0f / 127.0f);
    }
}

#ifndef W1_CLIP_SIGMAS
#define W1_CLIP_SIGMAS 4.0f
#endif
__device__ __forceinline__ void w1_colscale_all(const Frame& F, const Args& P) {
    const int gw = F.vcu * NWAVES + F.wave, NGW = F.G * NWAVES; constexpr int ncg = NUP / 256;
    for (int t = gw; t < 4 * ncg; t += NGW) { const int fi = t / ncg, cg = t - fi * ncg, l = fi >> 1, wh = fi & 1, c = cg * 256 + 4 * F.lane;
        const float* wp = P.in[wh ? 19 : 2] + (size_t)l * D * NUP + c; const float* ks = P.in[wh ? 18 : 1] + (size_t)l * D;
        f32x4 ss = {0.f, 0.f, 0.f, 0.f};
#pragma unroll 16
        for (int k = 0; k < D; k += 16) { const f32x4 v = *(const f32x4*)(wp + (size_t)k * NUP) * ks[k]; ss = ss + v * v; }
        const int half = c >= FF ? 1 : 0, cc = c - half * FF, dest = (cc >> 7) * 256 + half * 128 + (cc & 127);
        unsigned* cmax = (unsigned*)(P.ws + WS_WMAX) + (size_t)fi * NUP;
#pragma unroll
        for (int j = 0; j < 4; ++j) cmax[dest + j] = __float_as_uint(W1_CLIP_SIGMAS * sqrtf(ss[j] * (16.0f / D))); }
}
__device__ __forceinline__ void w1_colmax(const Frame& F, const Args& P, int fi) { const int l = fi >> 1, wh = fi & 1;
    colmax_job(F, P.in[wh ? 19 : 2] + (size_t)l * D * NUP, NUP, D, NUP, P.in[wh ? 18 : 1] + (size_t)l * D, (unsigned*)(P.ws + WS_WMAX) + (size_t)fi * NUP); }
__device__ __forceinline__ void w1_quant(const Frame& F, const Args& P, int fi) { const int l = fi >> 1, wh = fi & 1; unsigned char* ws = P.ws;
    transpose_job(F, P.in[wh ? 19 : 2] + (size_t)l * D * NUP, NUP, D, NUP, (bf16*)(ws + WS_W1T) + (size_t)fi * NUP * D, 0, P.in[wh ? 18 : 1] + (size_t)l * D, -1, 0, 0.f,
                  (const unsigned*)(ws + WS_WMAX) + (size_t)fi * NUP, 0, -1, 1, 1); }
__device__ __forceinline__ float sigmoidf_(float x) { return __builtin_amdgcn_rcpf(1.0f + __expf(-x)); }
__device__ __forceinline__ float gelu_tanh(float x) { const float z = 0.7978845608028654f * (x + 0.044715f * x * x * x); return x * __builtin_amdgcn_rcpf(1.0f + __expf(-2.0f * z)); }

__device__ __forceinline__ void lru_unit(const Frame& F, const Args& P, int l, int u) {
    typedef short bf16x8_t __attribute__((ext_vector_type(8)));
    const int g = u & 7, c = (u >> 3) & 31, b = u >> 8;
    const int t0 = c * 64; const size_t row0 = (size_t)b * SEQ + t0;
    const bf16* proj = (const bf16*)(P.ws + WS_PROJ);
    float* HL = (float*)(P.ws + WS_HL); float* PPp = (float*)(P.ws + WS_PP);
    const bf16* WG = (const bf16*)(P.ws + WS_WG);
    LAS float* xcf = (LAS float*)(F.lds + RING_OFF);
    LAS bf16* xcb = (LAS bf16*)(F.lds + RING_OFF + 32768);
    LAS bf16* xs = (LAS bf16*)(F.lds + RING_OFF + 50176);
    LAS float* Ul = (LAS float*)(F.lds + RING_OFF + 32768);
    LAS float* Al = (LAS float*)(F.lds + RING_OFF + 65536);
    const int w = F.wave, fr = F.lane & 15, fq = F.lane >> 4;
    bf16x8_t bfa[4], bfx[4];
    { const bf16* wa = WG + (((size_t)l * 2 + 0) * 8 + g) * 128 * 128 + (size_t)(16 * w + fr) * 128 + 8 * fq;
      const bf16* wx = WG + (((size_t)l * 2 + 1) * 8 + g) * 128 * 128 + (size_t)(16 * w + fr) * 128 + 8 * fq;
#pragma unroll
      for (int kk = 0; kk < 4; ++kk) { bfa[kk] = *(const bf16x8_t*)(wa + 32 * kk); bfx[kk] = *(const bf16x8_t*)(wx + 32 * kk); } }
    const int cc_ = 16 * w + fr, gc_ = g * 128 + cc_;
    const float ba_ = P.in[9][l * DL + gc_], bx_ = P.in[11][l * DL + gc_], lam_ = P.in[12][l * DL + gc_];
    for (int i = F.tid; i < 67 * 16; i += NWAVES * 64) { const int r = i >> 4, c8 = i & 15; const int t = t0 - 3 + r; v4u val = {0u, 0u, 0u, 0u};
        if (t >= 0) val = *(const v4u*)(proj + ((size_t)b * SEQ + t) * NIN + C_XA + g * 128 + c8 * 8);
        ((LAS v4u*)xs)[i] = val; }
    __syncthreads();
    const int ch = F.tid & 127, tq = F.tid >> 7, gch = g * 128 + ch;
    { const float* cw = P.in[6] + (size_t)l * 4 * DL; const float cb = P.in[7][l * DL + gch];
      const float w0 = cw[gch], w1 = cw[DL + gch], w2 = cw[2 * DL + gch], w3 = cw[3 * DL + gch];
#pragma unroll 4
      for (int tt = 0; tt < 16; ++tt) { const int t = tq * 16 + tt;
          const float v = cb + w0 * bf2f(xs[t * 128 + ch]) + w1 * bf2f(xs[(t + 1) * 128 + ch]) + w2 * bf2f(xs[(t + 2) * 128 + ch]) + w3 * bf2f(xs[(t + 3) * 128 + ch]);
          xcf[t * 128 + ch] = v; xcb[t * 136 + ch] = (bf16)(pg8::cvt_pk_bf16(v, v) & 0xffffu); } }
    __syncthreads();
    pg8::f32x4 accA[4], accX[4];
#pragma unroll
    for (int m = 0; m < 4; ++m) { accA[m] = (pg8::f32x4){0.f, 0.f, 0.f, 0.f}; accX[m] = accA[m]; }
#pragma unroll
    for (int kk = 0; kk < 4; ++kk) {
#pragma unroll
        for (int m = 0; m < 4; ++m) { const bf16x8_t af = *(const LAS bf16x8_t*)(xcb + (16 * m + fr) * 136 + 32 * kk + 8 * fq);
            accA[m] = __builtin_amdgcn_mfma_f32_16x16x32_bf16(af, bfa[kk], accA[m], 0, 0, 0); accX[m] = __builtin_amdgcn_mfma_f32_16x16x32_bf16(af, bfx[kk], accX[m], 0, 0, 0); } }
    __syncthreads();
    { const int cc = cc_; const float ba = ba_, bx = bx_;
      const float sp = __logf(1.0f + __expf(-lam_));
#pragma unroll
      for (int m = 0; m < 4; ++m)
#pragma unroll
          for (int j = 0; j < 4; ++j) { const int t = 16 * m + 4 * fq + j;
              const float r = sigmoidf_(accA[m][j] + ba), ig = sigmoidf_(accX[m][j] + bx);
              const float la = -8.0f * r * sp, a = __expf(la), mult = sqrtf(1.0f - a * a);
              Al[t * 128 + cc] = a; Ul[t * 128 + cc] = mult * (ig * xcf[t * 128 + cc]); } }
    __syncthreads();
    float hs[16], ps[16];
    { float h = 0.f, p = 1.f;
#pragma unroll
      for (int tt = 0; tt < 16; ++tt) { const int t = tq * 16 + tt; const float a = Al[t * 128 + ch], uu = Ul[t * 128 + ch]; h = a * h + uu; p *= a; hs[tt] = h; ps[tt] = p; }
      if (tq < 3) { Ul[(tq * 16 + 15) * 128 + ch] = h; Al[(tq * 16 + 15) * 128 + ch] = p; } }
    __syncthreads();
    { float cin = 0.f, pin = 1.f;
      for (int qq = 0; qq < tq; ++qq) { const float pa = Al[(qq * 16 + 15) * 128 + ch], hu = Ul[(qq * 16 + 15) * 128 + ch]; cin = pa * cin + hu; pin *= pa; }
#pragma unroll
      for (int tt = 0; tt < 16; ++tt) { const size_t o = (row0 + tq * 16 + tt) * DL + gch; HL[o] = hs[tt] + ps[tt] * cin; PPp[o] = ps[tt] * pin; } }
    __syncthreads();
}

__device__ __forceinline__ void attn_phase(const Frame& F, const Args& P, char* lds) {
    const bf16* proj = (const bf16*)(P.ws + WS_PROJ); const float* lf = (const float*)(P.ws + WS_LF);
    bf16* YB = (bf16*)(P.ws + WS_YB); bf16* YCP = (bf16*)(P.ws + WS_YCP); float* LSE = (float*)(P.ws + WS_LSE);
    for (int it = F.bx; it < BATCH * NFX * 4; it += F.G) {
        const int bh = it >> 2, x = it & 3, b = bh >> 3, h = bh & 7; const size_t rb = (size_t)b * SEQ;
        if (F.wave == 0) { LAS float* kbl = (LAS float*)(F.lds + RING_OFF + att::KB_OFF);
            const float* lp = lf + (rb + 32 * F.lane) * 8 + h; float loc[32]; float run = 0.f;
#pragma unroll
            for (int i = 0; i < 32; ++i) { run += lp[(size_t)i * 8]; loc[i] = run; }
            float inc = run;
#pragma unroll
            for (int o = 1; o < 64; o <<= 1) { const float t = __shfl_up(inc, o); if (F.lane >= o) inc += t; }
            const float excl = inc - run;
#pragma unroll
            for (int i = 0; i < 32; ++i) kbl[32 * F.lane + i] = -(excl + loc[i]) * (1.0f / att::SCALE); }
#pragma unroll 1
        for (int pass = 0; pass < 2; ++pass) { const int qb = pass ? x : 7 - x;
            att::Blk B;
            B.Q = proj + (rb + 256 * qb) * NIN + C_QF + h * 128; B.K = proj + rb * NIN + C_KF + h * 128; B.V = proj + rb * NIN + C_VF + h * 128;
            B.O = YB + (rb + 256 * qb) * DFX + h * 128; B.L = nullptr;
            B.qstride = NIN; B.kstride = NIN; B.ostride = DFX; B.lstride = 0; B.pair_off = 0; B.opair_off = 0; B.lpair_off = 0;
            B.P0 = 256 * qb; B.j_lo = 0; B.NT = 4 * (qb + 1); B.W = 1 << 20; B.pair = 0; B.kbias = nullptr;
            att::attn_block<true>(B, lds); }
    }
#pragma unroll 1
    for (int bi = F.bx; bi < BATCH * NDL * 24; bi += F.G) {
        const int bh = bi / 24, k = bi - bh * 24, b = bh >> 4, hh = bh & 15; const size_t rb = (size_t)b * SEQ;
        int pi, d, res, qb, pair;
        if (k < 8) { pi = 0; d = 1; res = 0; qb = k; pair = 0; }
        else if (k < 16) { pi = 1; d = 4; res = (k - 8) >> 1; qb = (k - 8) & 1; pair = 0; }
        else { pi = 2; d = 16; res = 2 * (k - 16); qb = 0; pair = 1; }
        const size_t r0 = rb + res + (size_t)(256 * qb) * d;
        att::Blk B;
        B.Q = proj + r0 * NIN + C_QD + hh * 128; B.K = proj + (rb + res) * NIN + C_KD + hh * 128; B.V = proj + (rb + res) * NIN + C_VD + hh * 128;
        B.O = YCP + (size_t)pi * M * DDL + r0 * DDL + hh * 128; B.L = LSE + (size_t)pi * M * NDL + r0 * NDL + hh;
        B.qstride = d * NIN; B.kstride = d * NIN; B.ostride = d * DDL; B.lstride = d * NDL; B.pair_off = NIN; B.opair_off = DDL; B.lpair_off = NDL;
        B.P0 = 256 * qb; B.W = 129; B.pair = pair; B.kbias = nullptr;
        if (pair) { B.j_lo = 0; B.NT = 4; }
        else { const int lowk = B.P0 - 129 + 1; B.j_lo = lowk > 0 ? lowk / 64 : 0; B.NT = (B.P0 + 255) / 64 + 1 - B.j_lo; }
        att::attn_block<false>(B, lds);
    }
}

__device__ __forceinline__ void merge_unit(const Frame& F, const Args& P, int l, int u) {
    const int c = u & 31, b = u >> 5; const size_t rb = (size_t)b * SEQ;
    const bf16* proj = (const bf16*)(P.ws + WS_PROJ); const float* HL = (const float*)(P.ws + WS_HL); const float* PPp = (const float*)(P.ws + WS_PP);
    const bf16* YB = (const bf16*)(P.ws + WS_YB); const bf16* YCP = (const bf16*)(P.ws + WS_YCP); const float* LSE = (const float*)(P.ws + WS_LSE); bf16* Y = (bf16*)(P.ws + WS_A1);
    LAS float* hin = (LAS float*)(F.lds + RING_OFF);
    for (int ch = F.tid; ch < DL; ch += NWAVES * 64) { float h = 0.f;
        for (int c0 = 0; c0 < c; c0 += 8) { float pa[8], ha[8];
#pragma unroll
            for (int k = 0; k < 8; ++k) { const int cc = (c0 + k < c) ? c0 + k : c - 1; const size_t r = (rb + 64 * cc + 63) * DL + ch; pa[k] = PPp[r]; ha[k] = HL[r]; }
#pragma unroll
            for (int k = 0; k < 8; ++k) if (c0 + k < c) h = pa[k] * h + ha[k]; }
        hin[ch] = h; }
    __syncthreads();
    const float* g_a = P.in[14] + (size_t)l * DL; const float* g_b = P.in[15] + (size_t)l * DFX; const float* g_c = P.in[16] + (size_t)l * DDL;
    const int lane = F.lane;
    for (int rr = F.wave; rr < 64; rr += NWAVES) { const size_t row = rb + 64 * c + rr;
        { f32x4 y[4]; float ss = 0.f;
#pragma unroll
          for (int j = 0; j < 4; ++j) { const int chb = 4 * lane + 256 * j;
              const f32x4 hl = *(const f32x4*)(HL + row * DL + chb), pp = *(const f32x4*)(PPp + row * DL + chb), hi = *(const LAS f32x4*)(hin + chb);
              const uint2 gw = *(const uint2*)(proj + row * NIN + C_GA + chb);
              f32x4 hv = hl + pp * hi;
              y[j] = (f32x4){hv.x * gelu_tanh(bf_lo(gw.x)), hv.y * gelu_tanh(bf_hi(gw.x)), hv.z * gelu_tanh(bf_lo(gw.y)), hv.w * gelu_tanh(bf_hi(gw.y))};
              ss += (y[j].x * y[j].x + y[j].y * y[j].y) + (y[j].z * y[j].z + y[j].w * y[j].w); }
          const float rstd = 1.0f / sqrtf(wave_sum(ss) * (1.0f / DL) + EPS);
#pragma unroll
          for (int j = 0; j < 4; ++j) { const int chb = 4 * lane + 256 * j; const f32x4 o = y[j] * rstd * *(const f32x4*)(g_a + chb);
              *(unsigned long long*)(Y + row * D + chb) = (unsigned long long)pg8::cvt_pk_bf16(o.x, o.y) | ((unsigned long long)pg8::cvt_pk_bf16(o.z, o.w) << 32); } }
        { f32x4 y[4]; float ss = 0.f;
#pragma unroll
          for (int j = 0; j < 4; ++j) { const int chb = 4 * lane + 256 * j; const uint2 w = *(const uint2*)(YB + row * DFX + chb);
              y[j] = (f32x4){bf_lo(w.x), bf_hi(w.x), bf_lo(w.y), bf_hi(w.y)};
              ss += (y[j].x * y[j].x + y[j].y * y[j].y) + (y[j].z * y[j].z + y[j].w * y[j].w); }
          const float rstd = 1.0f / sqrtf(wave_sum(ss) * (1.0f / DFX) + EPS);
#pragma unroll
          for (int j = 0; j < 4; ++j) { const int chb = 4 * lane + 256 * j; const f32x4 o = y[j] * rstd * *(const f32x4*)(g_b + chb);
              *(unsigned long long*)(Y + row * D + DL + chb) = (unsigned long long)pg8::cvt_pk_bf16(o.x, o.y) | ((unsigned long long)pg8::cvt_pk_bf16(o.z, o.w) << 32); } }
        { f32x4 y[8]; float ss = 0.f;
#pragma unroll
          for (int j = 0; j < 8; ++j) { const int chb = 4 * lane + 256 * j, head = 2 * j + (lane >> 5);
              const float l0 = LSE[row * NDL + head], l1 = LSE[(size_t)M * NDL + row * NDL + head], l2 = LSE[(size_t)2 * M * NDL + row * NDL + head];
              const float lm = fmaxf(l0, fmaxf(l1, l2)); float w0 = __expf(l0 - lm), w1 = __expf(l1 - lm), w2 = __expf(l2 - lm); const float wi = 1.0f / (w0 + w1 + w2); w0 *= wi; w1 *= wi; w2 *= wi;
              const uint2 a0 = *(const uint2*)(YCP + row * DDL + chb), a1 = *(const uint2*)(YCP + (size_t)M * DDL + row * DDL + chb), a2 = *(const uint2*)(YCP + (size_t)2 * M * DDL + row * DDL + chb);
              y[j] = (f32x4){w0 * bf_lo(a0.x) + w1 * bf_lo(a1.x) + w2 * bf_lo(a2.x), w0 * bf_hi(a0.x) + w1 * bf_hi(a1.x) + w2 * bf_hi(a2.x),
                             w0 * bf_lo(a0.y) + w1 * bf_lo(a1.y) + w2 * bf_lo(a2.y), w0 * bf_hi(a0.y) + w1 * bf_hi(a1.y) + w2 * bf_hi(a2.y)};
              ss += (y[j].x * y[j].x + y[j].y * y[j].y) + (y[j].z * y[j].z + y[j].w * y[j].w); }
          const float rstd = 1.0f / sqrtf(wave_sum(ss) * (1.0f / DDL) + EPS);
#pragma unroll
          for (int j = 0; j < 8; ++j) { const int chb = 4 * lane + 256 * j; const f32x4 o = y[j] * rstd * *(const f32x4*)(g_c + chb);
              *(unsigned long long*)(Y + row * D + DL + DFX + chb) = (unsigned long long)pg8::cvt_pk_bf16(o.x, o.y) | ((unsigned long long)pg8::cvt_pk_bf16(o.z, o.w) << 32); } }
    }
    __syncthreads();
}
#ifndef TAIL_SPLIT_PCT
#define TAIL_SPLIT_PCT 75
#endif
#ifndef WGM_OUT
#define WGM_OUT 8
#endif
#ifndef WGM_IN
#define WGM_IN 8
#endif
#ifndef WGM_UP
#define WGM_UP 8
#endif
#ifndef WGM_DOWN
#define WGM_DOWN 2
#endif
#ifndef PG8_ALIGN_UP
#define PG8_ALIGN_UP false
#endif
#ifndef PG8_SP2
#define PG8_SP2 true
#endif
#ifndef PG8_ALIGN
#define PG8_ALIGN true
#endif
__global__ void __launch_bounds__(NWAVES * 64, 2) hymba_fwd(Args args) {
    extern __shared__ __attribute__((aligned(16))) unsigned char lds[];
    Frame F;
#define FRESH_F() do { int tz_ = threadIdx.x; asm volatile("" : "+v"(tz_)); int g_ = gridDim.x, bx_ = blockIdx.x; asm volatile("" : "+s"(g_), "+s"(bx_)); \
        F.lds = (LAS unsigned char*)lds; F.tid = tz_; F.lane = tz_ & 63; F.wave = __builtin_amdgcn_readfirstlane(tz_ >> 6); F.G = g_; F.bx = bx_; \
        F.vcu = (g_ % 8 == 0) ? (bx_ % 8) * (g_ / 8) + bx_ / 8 : bx_; } while (0)
    FRESH_F();
    const Args& P = args;
    unsigned char* ws = args.ws;
    gu32* ctl = (gu32*)(ws + WS_CTL);
    volatile LAS unsigned* MISC = (volatile LAS unsigned*)(F.lds + MISC_OFF);
    for (int u = F.tid; u < (LDS_BYTES - LDSCTL_OFF) / 4; u += NWAVES * 64) ((LAS unsigned*)(F.lds + LDSCTL_OFF))[u] = 0u;
    __syncthreads();
    XcdBarrier bar = xcd_barrier_post((unsigned*)(ctl + CW_BAR) + args.li * XCD_BAR_WORDS, MISC + 8);
    const int lo = args.ph_lo, hi = args.ph_hi;
    int pc = 0;
#define PH_ON() (pc >= lo && pc < hi)
#ifndef EN_MASK
#define EN_MASK 0x3ff
#endif
#define EN(k) (((EN_MASK) >> (k)) & 1)
#ifndef REP_MASK
#define REP_MASK 0
#endif
#define REP(k) (1 + (((REP_MASK) >> (k)) & 1))
#ifdef PROBE_PC
    unsigned long long pr_prev_ = __builtin_amdgcn_s_memrealtime(), pr_acc_ = 0, pc_prev_ = __builtin_amdgcn_s_memtime(), pc_acc_ = 0;
#ifdef PROBE_INCL_BAR
#define PH_END() do { if (PH_ON() && pc + 1 < hi) xcd_barrier(bar); { const unsigned long long nowc_ = __builtin_amdgcn_s_memtime(), now_ = __builtin_amdgcn_s_memrealtime(); if (PROBE_PC(pc)) { pr_acc_ += now_ - pr_prev_; pc_acc_ += nowc_ - pc_prev_; } } \
        pr_prev_ = __builtin_amdgcn_s_memrealtime(); pc_prev_ = __builtin_amdgcn_s_memtime(); ++pc; } while (0)
#else
#define PH_END() do { { const unsigned long long nowc_ = __builtin_amdgcn_s_memtime(), now_ = __builtin_amdgcn_s_memrealtime(); if (PROBE_PC(pc)) { pr_acc_ += now_ - pr_prev_; pc_acc_ += nowc_ - pc_prev_; } } \
        if (PH_ON() && pc + 1 < hi) xcd_barrier(bar); pr_prev_ = __builtin_amdgcn_s_memrealtime(); pc_prev_ = __builtin_amdgcn_s_memtime(); ++pc; } while (0)
#endif
#else
#define PH_END() do { if (PH_ON() && pc + 1 < hi) xcd_barrier(bar); ++pc; } while (0)
#endif

    bf16* W1T = (bf16*)(ws + WS_W1T); bf16* W2T = (bf16*)(ws + WS_W2T); bf16* WIN = (bf16*)(ws + WS_WIN); bf16* WOUT = (bf16*)(ws + WS_WOUT);
    bf16* A1 = (bf16*)(ws + WS_A1); bf16* HB = (bf16*)(ws + WS_HB); unsigned char* HB8 = ws + WS_HB8; float* ASC = (float*)(ws + WS_ASC); unsigned long long* SSQ = (unsigned long long*)(ws + WS_SSQ); bf16* ACT = (bf16*)(ws + WS_ACT); bf16* PROJ = (bf16*)(ws + WS_PROJ);
    const float* rope_c = (const float*)(ws + WS_ROPE); const float* rope_s = rope_c + SEQ * 16;
    float* LFp = (float*)(ws + WS_LF);

    static_assert(I8_UP_MASK == 0xF, "this phase program makes an int8 copy of every FFN's up weights");
    if (PH_ON() && EN(0)) { FRESH_F(); w1_colscale_all(F, P); }
    PH_END();
    if (PH_ON() && EN(0)) {
#pragma unroll 1
        for (int fq_ = 0; fq_ < 4; ++fq_) { FRESH_F(); w1_quant(F, P, fq_); }
        FRESH_F(); p0_prologue(F, P); }
    PH_END();

#pragma unroll
    for (int fi = 0; fi < 4; ++fi) {
        const int l = fi >> 1, wh = fi & 1;
        if (PH_ON() && EN(1)) { FRESH_F(); if (fi > 0 && ((I8_UP_MASK >> fi) & 1)) quant_rows(F, HB, HB8, ASC); }
        PH_END();
        if (PH_ON() && EN(2)) for (int rep_ = 0; rep_ < REP(2); ++rep_) { if (rep_) xcd_barrier(bar); FRESH_F(); pg8::StaticOrder S; S.init(M, NUP, F.G, (int)F.bx, WGM_UP);
            static_assert((FP8_DOWN_MASK & ~(FP8_UP_MASK | I8_UP_MASK)) == 0 && (FP8_UP_MASK & I8_UP_MASK) == 0, "an fp8 down GEMM takes its A operand from an fp8 or int8 up GEMM's epilogue in this build");
            if (I8_UP_MASK == 0xF || ((I8_UP_MASK >> fi) & 1)) { pg8::Gemm g{(const bf16*)HB8, W1T + (size_t)fi * NUP * D, M, NUP, D / 2};
                const float* wmx = (const float*)(ws + WS_WMAX) + (size_t)fi * NUP;
                if ((FP8_DOWN_MASK >> fi) & 1) { pg8::EpiSwiglu<true, true> E{ACT, FF / 128, SSQ + (size_t)(3 * l + 2 * wh) * M, 1.0f / (1048576.0f * D), EPS, 1.0f, FP8_ACT_MUL, ASC, wmx};
                    pg8::gemm_phase<pg8::EpiSwiglu<true, true>, pg8::StaticOrder, PG8_ALIGN_UP, PG8_SP2, false, true, true>(F.lds + RING_OFF, g, S, E); }
                else { pg8::EpiSwiglu<false, true> E{ACT, FF / 64, SSQ + (size_t)(3 * l + 2 * wh) * M, 1.0f / (1048576.0f * D), EPS, 1.0f, 1.0f, ASC, wmx};
                    pg8::gemm_phase<pg8::EpiSwiglu<false, true>, pg8::StaticOrder, PG8_ALIGN_UP, PG8_SP2, false, true, true>(F.lds + RING_OFF, g, S, E); } }
            else if ((FP8_UP_MASK >> fi) & 1) { pg8::Gemm g{(const bf16*)HB8, W1T + (size_t)fi * NUP * D, M, NUP, D / 2};
                if ((FP8_DOWN_MASK >> fi) & 1) { pg8::EpiSwiglu<true> E{ACT, FF / 128, SSQ + (size_t)(3 * l + 2 * wh) * M, 1.0f / (1048576.0f * D), EPS, 1.0f / FP8_WMUL, FP8_ACT_MUL, nullptr, nullptr};
                    pg8::gemm_phase<pg8::EpiSwiglu<true>, pg8::StaticOrder, PG8_ALIGN_UP, PG8_SP2, true>(F.lds + RING_OFF, g, S, E); }
                else { pg8::EpiSwiglu<false> E{ACT, FF / 64, SSQ + (size_t)(3 * l + 2 * wh) * M, 1.0f / (1048576.0f * D), EPS, 1.0f / FP8_WMUL, 1.0f, nullptr, nullptr};
                    pg8::gemm_phase<pg8::EpiSwiglu<false>, pg8::StaticOrder, PG8_ALIGN_UP, PG8_SP2, true>(F.lds + RING_OFF, g, S, E); } }
            else { pg8::Gemm g{HB, W1T + (size_t)fi * NUP * D, M, NUP, D};
                pg8::EpiSwiglu<false> E{ACT, FF / 64, SSQ + (size_t)(3 * l + 2 * wh) * M, 1.0f / (1048576.0f * D), EPS, 1.0f, 1.0f, nullptr, nullptr};
                pg8::gemm_phase<pg8::EpiSwiglu<false>, pg8::StaticOrder, PG8_ALIGN_UP, PG8_SP2>(F.lds + RING_OFF, g, S, E); }
            { const int nwg_ = (M / 256) * (NUP / 256), full_ = nwg_ / F.G, extra_ = nwg_ - full_ * F.G;
              const float* Wsrc = P.in[wh ? 20 : 3] + (size_t)l * FF * D; bf16* Wdst = W2T + (size_t)fi * D * FF;
              const float f8m_ = ((FP8_DOWN_MASK >> fi) & 1) ? FP8_WMUL_DOWN : 0.f;
              if (extra_ > 0 && extra_ < F.G) { const int nit_ = (FF / 64) * (D / 64), split_ = (nit_ * TAIL_SPLIT_PCT) / 100;
                  if (F.bx >= extra_) transpose_job(F, Wsrc, D, FF, D, Wdst, 1, nullptr, (F.bx - extra_) * NWAVES + F.wave, (F.G - extra_) * NWAVES, f8m_, nullptr, 0, split_, 1);
                  else transpose_job(F, Wsrc, D, FF, D, Wdst, 1, nullptr, F.bx * NWAVES + F.wave, extra_ * NWAVES, f8m_, nullptr, split_, nit_, 1); }
              else transpose_job(F, Wsrc, D, FF, D, Wdst, 1, nullptr, -1, 0, f8m_, nullptr, 0, -1, 1); }
            }
        PH_END();
        if (PH_ON() && EN(3)) { FRESH_F(); pg8::StaticOrder S; S.init(M, D, F.G, (int)F.bx, WGM_DOWN);
            if ((FP8_DOWN_MASK >> fi) & 1) { pg8::Gemm g{ACT, W2T + (size_t)fi * D * FF, M, D, FF / 2};
                pg8::EpiResidB E{HB, D, 0.5f / (FP8_WMUL_DOWN * FP8_ACT_MUL), SSQ + (size_t)(3 * l + 2 * wh + 1) * M, HB8};
                pg8::gemm_phase<pg8::EpiResidB, pg8::StaticOrder, PG8_ALIGN, PG8_SP2, true, false, true>(F.lds + RING_OFF, g, S, E); }
            else { pg8::Gemm g{ACT, W2T + (size_t)fi * D * FF, M, D, FF};
                pg8::EpiResidB E{HB, D, 0.5f, SSQ + (size_t)(3 * l + 2 * wh + 1) * M, HB8};
                pg8::gemm_phase<pg8::EpiResidB, pg8::StaticOrder, PG8_ALIGN, PG8_SP2, false, false, true>(F.lds + RING_OFF, g, S, E); } }
        PH_END();
        if (wh == 0) {
            if (PH_ON() && EN(5)) for (int rep_ = 0; rep_ < REP(5); ++rep_) { if (rep_) xcd_barrier(bar); FRESH_F();
                ff_rows(F, HB, SSQ + (size_t)(3 * l + 1) * M, (const float*)(ws + WS_WFF) + (size_t)l * 8 * D, P.in[13] + l * 8, LFp);
                pg8::Gemm g{HB, WIN + (size_t)l * NIN * D, M, NIN, D}; pg8::StaticOrder S; S.init(M, NIN, F.G, (int)F.bx, WGM_IN);
                pg8::EpiProj E{PROJ, NIN, rope_c, rope_s, C_QD / 256, C_VD / 256, SSQ + (size_t)(3 * l + 1) * M, 1.0f / (1048576.0f * D), EPS};
                pg8::gemm_phase<pg8::EpiProj, pg8::StaticOrder, PG8_ALIGN, PG8_SP2>(F.lds + RING_OFF, g, S, E); }
            PH_END();
            if (PH_ON() && EN(6)) for (int rep_ = 0; rep_ < REP(6); ++rep_) { if (rep_) xcd_barrier(bar); FRESH_F();
                for (int u = F.bx; u < BATCH * 32 * 8; u += F.G) lru_unit(F, P, l, u);
                attn_phase(F, P, (char*)lds);
            }
            PH_END();
            if (PH_ON() && EN(7)) for (int rep_ = 0; rep_ < REP(7); ++rep_) { if (rep_) xcd_barrier(bar); FRESH_F(); for (int u = F.bx; u < BATCH * 32; u += F.G) merge_unit(F, P, l, u); }
            PH_END();
            if (PH_ON() && EN(8)) { FRESH_F(); pg8::Gemm g{A1, WOUT + (size_t)l * D * D, M, D, D}; pg8::StaticOrder S; S.init(M, D, F.G, (int)F.bx, WGM_OUT);
                pg8::EpiResidB E{HB, D, 1.0f, SSQ + (size_t)(3 * l + 2) * M, HB8};
                pg8::gemm_phase<pg8::EpiResidB, pg8::StaticOrder, PG8_ALIGN, PG8_SP2>(F.lds + RING_OFF, g, S, E); }
            PH_END();
        }
    }
#ifdef PROBE_BAR
    for (int i_ = 0; i_ < PROBE_BAR; ++i_) xcd_barrier(bar);
#endif
    if (PH_ON() && EN(9)) { FRESH_F(); final_rows(F, HB, SSQ + (size_t)6 * M, P.in[21], P.out); }
    PH_END();
#ifdef PROBE_PC
#ifdef PROBE_AS_CLK
    pr_acc_ = (pc_acc_ * 100ull / (pr_acc_ ? pr_acc_ : 1ull)) * 100ull;
#endif
    if (blockIdx.x == 0 && threadIdx.x == 0) { const unsigned long long t0 = __builtin_amdgcn_s_memrealtime(); while (__builtin_amdgcn_s_memrealtime() - t0 < pr_acc_) __builtin_amdgcn_s_sleep(32); }
#endif
#undef PH_ON
#undef PH_END
}

constexpr int N_PHASES = 2 + 4 * 3 + 2 * 4 + 1;
extern "C" void kernel_launch(void* const* d_in, const int* in_sizes, int n_in, void* d_out, int out_size, void* d_ws, size_t ws_size, hipStream_t stream) {
    static int grid = 0;
    if (grid == 0) {
        if (n_in != 22 || in_sizes[0] != M * D || out_size != M * D || ws_size < WS_END) {
            fprintf(stderr, "kernel_launch: shape/workspace mismatch: n_in %d in0 %d out %d ws %zu (need %zu); nothing launched\n", n_in, n_in > 0 ? in_sizes[0] : -1, out_size, ws_size, (size_t)WS_END); grid = -1; return; }
        int dev = 0, cus = 0, per_cu = 0;
        if (hipGetDevice(&dev) != hipSuccess || hipDeviceGetAttribute(&cus, hipDeviceAttributeMultiprocessorCount, dev) != hipSuccess) { grid = -1; return; }
        if (hipFuncSetAttribute((const void*)hymba_fwd, hipFuncAttributeMaxDynamicSharedMemorySize, LDS_BYTES) != hipSuccess) { fprintf(stderr, "kernel_launch: hipFuncSetAttribute failed\n"); grid = -1; return; }
        if (hipOccupancyMaxActiveBlocksPerMultiprocessor(&per_cu, (const void*)hymba_fwd, NWAVES * 64, LDS_BYTES) != hipSuccess || per_cu < 1) {
            fprintf(stderr, "kernel_launch: occupancy query reports %d workgroups per CU\n", per_cu); }
        (void)hipGetLastError();
        grid = cus;
    }
    if (grid < 0) return;
    if (hipMemsetAsync((char*)d_ws + WS_CTL, 0, CTL_ZERO_BYTES, stream) != hipSuccess) return;
    Args a{};
    for (int i = 0; i < 22; ++i) a.in[i] = (const float*)d_in[i];
    a.out = (float*)d_out; a.ws = (unsigned char*)d_ws;
#ifndef MK_CUTS
    a.ph_lo = 0; a.ph_hi = N_PHASES; a.li = 0; a.pad = 0;
    hipLaunchKernelGGL(hymba_fwd, dim3(grid), dim3(NWAVES * 64), LDS_BYTES, stream, a);
#else
    { const int cuts[] = {MK_CUTS, N_PHASES}; int lo = 0;
      for (int li = 0; li < (int)(sizeof(cuts) / sizeof(int)); ++li) { a.ph_lo = lo; a.ph_hi = cuts[li]; a.li = li; a.pad = 0; lo = cuts[li];
          hipLaunchKernelGGL(hymba_fwd, dim3(grid), dim3(NWAVES * 64), LDS_BYTES, stream, a); } }
#endif
}
```

```cpp
#include <hip/hip_runtime.h>
#include <cstdio>
#include <cstdint>
namespace pg8 {
#define PG8_LAS __attribute__((address_space(3)))
typedef unsigned short bf16_t;
typedef short bf16x8 __attribute__((ext_vector_type(8)));
typedef float f32x4 __attribute__((ext_vector_type(4)));
typedef unsigned u32x4 __attribute__((ext_vector_type(4)));
constexpr int BM = 256, BK = 64, HALF = 128, HTB = HALF * BK * 2  , STAGE_BYTES = 8 * HTB, NXCD = 8, WGM = 8;

__host__ __device__ __forceinline__ int lds_byte(int r, int c) { const int st = (r >> 4) * 2 + (c >> 5), rr = r & 15, cc = c & 31, ob = rr * 64 + cc * 2; return st * 1024 + (ob ^ (((ob >> 9) & 1) << 5)); }
__host__ __device__ __forceinline__ void stage_rc(int b, int& R, int& C) { const int st = b / 1024, sb = b % 1024, swz = sb ^ (((sb >> 9) & 1) << 5); R = (st >> 1) * 16 + swz / 64; C = (st & 1) * 32 + (swz % 64) / 2; }
__host__ __device__ __forceinline__ int perm32(int rho) { const int n = rho >> 4, i = rho & 15; return 8 * (i >> 2) + 4 * n + (i & 3); }

struct Unit { int pm, pn; };
struct Gemm { const bf16_t* A; const bf16_t* Bt; int M, N, K; };

struct StaticOrder {
    int nM, nN, nwg, G, c, wgm;
    __host__ __device__ void init(int M, int N, int G_, int c_, int wgm_ = WGM) { nM = M / BM; nN = N / BM; nwg = nM * nN; G = G_; c = c_; wgm = wgm_; }
    __host__ __device__ bool next(int i, Unit& u) const {
        const long L = (long)i * G + c; if (L >= nwg) return false;
        int wgid = (int)L; { const int q = nwg / NXCD, r = nwg % NXCD, xcd = wgid % NXCD, off = wgid / NXCD; wgid = (xcd < r ? xcd * (q + 1) : r * (q + 1) + (xcd - r) * q) + off; }
        const int nig = wgm * nN, gid = wgid / nig, fm = gid * wgm, gsz = (nM - fm) < wgm ? (nM - fm) : wgm;
        u.pm = fm + ((wgid % nig) % gsz); u.pn = (wgid % nig) / gsz; return true;
    }
    __device__ __forceinline__ void a_ready(const Unit&) const {}
    __device__ __forceinline__ void done(const Unit&) const {}
};

__device__ __forceinline__ unsigned cvt_pk_bf16(float lo, float hi) { unsigned r; asm volatile("v_cvt_pk_bf16_f32 %0, %1, %2" : "=v"(r) : "v"(lo), "v"(hi)); return r; }
typedef float f32x2 __attribute__((ext_vector_type(2)));
template <bool OUT8, bool I8 = false> struct EpiSwiglu {
    static constexpr bool PERM = true, AFTER_DRAIN = false, PROBE_TWICE = true;
    bf16_t* O; int ldc; const unsigned long long* ssq; float inv_k, eps, wscale, oscale; const float* ascale; const float* wmax;
    __device__ __forceinline__ void operator()(const f32x4 (&acc)[2][2][4][2], const Unit& u, int wr, int wc, int fr, int fq) const {
        const int row0 = u.pm * BM + wr * 64 + fr, col0 = u.pn * HALF + wc * 32 + 8 * fq;
        float rs[2][4];
#pragma unroll
        for (int ai = 0; ai < 2; ++ai)
#pragma unroll
            for (int m = 0; m < 4; ++m) { rs[ai][m] = __builtin_amdgcn_rsqf((float)(unsigned)(ssq[row0 + ai * HALF + m * 16] >> 12) * (inv_k * 4096.0f) + eps) * wscale; if constexpr (I8) rs[ai][m] *= ascale[row0 + ai * HALF + m * 16]; }
        const int cb_ = OUT8 ? (u.pn * HALF + wc * 32 + 8 * fq) : 2 * (u.pn * HALF + wc * 32 + 8 * fq);
        const size_t eb0 = ((size_t)(u.pm * ldc + (cb_ >> 7)) * 256 + wr * 64 + fr) * 128 + (cb_ & 127);
        f32x4 cg[2], cu[2];
        if constexpr (I8) {
#pragma unroll
            for (int n = 0; n < 2; ++n) { cg[n] = *(const f32x4*)(wmax + u.pn * BM + wc * 32 + 8 * fq + 4 * n) * (1.0f / 127.0f); cu[n] = *(const f32x4*)(wmax + u.pn * BM + HALF + wc * 32 + 8 * fq + 4 * n) * (1.0f / 127.0f); } }
#pragma unroll
        for (int ai = 0; ai < 2; ++ai)
#pragma unroll
            for (int m = 0; m < 4; ++m) {
                const size_t eoffb = eb0 + (size_t)((ai * HALF + m * 16) * 128);
                float r[8];
#pragma unroll
                for (int n = 0; n < 2; ++n)
#pragma unroll
                    for (int j = 0; j < 4; ++j) { float g = acc[ai][0][m][n][j], up = acc[ai][1][m][n][j];
                        if constexpr (I8) { g = (float)__float_as_int(g) * cg[n][j]; up = (float)__float_as_int(up) * cu[n][j]; }
                        r[n * 4 + j] = (g * up) * (__builtin_amdgcn_rcpf(1.0f + __builtin_amdgcn_exp2f(g * (rs[ai][m] * -1.4426950408889634f))) * (rs[ai][m] * rs[ai][m])); }
                if constexpr (OUT8) { int p0 = 0, p1 = 0;
                    p0 = __builtin_amdgcn_cvt_pk_fp8_f32(r[0] * oscale, r[1] * oscale, p0, false); p0 = __builtin_amdgcn_cvt_pk_fp8_f32(r[2] * oscale, r[3] * oscale, p0, true);
                    p1 = __builtin_amdgcn_cvt_pk_fp8_f32(r[4] * oscale, r[5] * oscale, p1, false); p1 = __builtin_amdgcn_cvt_pk_fp8_f32(r[6] * oscale, r[7] * oscale, p1, true);
                    typedef unsigned u32x2_ __attribute__((ext_vector_type(2)));
                    *(u32x2_*)((unsigned char*)O + eoffb) = (u32x2_){(unsigned)p0, (unsigned)p1}; }
                else { u32x4 w; w.x = cvt_pk_bf16(r[0], r[1]); w.y = cvt_pk_bf16(r[2], r[3]); w.z = cvt_pk_bf16(r[4], r[5]); w.w = cvt_pk_bf16(r[6], r[7]);
                    *(u32x4*)((unsigned char*)O + eoffb) = w; } }
    }
};
struct EpiResid {
    static constexpr bool PERM = false, AFTER_DRAIN = false, PROBE_TWICE = false;
    const float* base; float* out; int ldc; float s;
    __device__ __forceinline__ void operator()(const f32x4 (&acc)[2][2][4][2], const Unit& u, int wr, int wc, int fr, int fq) const {
        const int row0 = u.pm * BM + wr * 64 + fr, col0 = u.pn * BM + wc * 32 + 4 * fq;
#pragma unroll
        for (int ai = 0; ai < 2; ++ai) {
            f32x4 b[4][2][2];
#pragma unroll
            for (int m = 0; m < 4; ++m) { const size_t off = (size_t)(row0 + ai * HALF + m * 16) * ldc + col0;
#pragma unroll
                for (int bj = 0; bj < 2; ++bj)
#pragma unroll
                    for (int n = 0; n < 2; ++n) b[m][bj][n] = *(const f32x4*)(base + off + bj * HALF + n * 16); }
#pragma unroll
            for (int m = 0; m < 4; ++m) { const size_t off = (size_t)(row0 + ai * HALF + m * 16) * ldc + col0;
#pragma unroll
                for (int bj = 0; bj < 2; ++bj)
#pragma unroll
                    for (int n = 0; n < 2; ++n) *(f32x4*)(out + off + bj * HALF + n * 16) = b[m][bj][n] + acc[ai][bj][m][n] * s; }
            asm volatile("" ::: "memory"); }
    }
};
struct EpiDelta {
    static constexpr bool PERM = true, AFTER_DRAIN = false, PROBE_TWICE = false;
    bf16_t* O; int ldc; float s;
    __device__ __forceinline__ void operator()(const f32x4 (&acc)[2][2][4][2], const Unit& u, int wr, int wc, int fr, int fq) const {
        const int row0 = u.pm * BM + wr * 64 + fr, col0 = u.pn * BM + wc * 32 + 8 * fq;
#pragma unroll
        for (int ai = 0; ai < 2; ++ai)
#pragma unroll
            for (int m = 0; m < 4; ++m) { bf16_t* rowp = O + (size_t)(row0 + ai * HALF + m * 16) * ldc + col0;
#pragma unroll
                for (int bj = 0; bj < 2; ++bj) { const f32x4 v0 = acc[ai][bj][m][0] * s, v1 = acc[ai][bj][m][1] * s;
                    u32x4 w; w.x = cvt_pk_bf16(v0[0], v0[1]); w.y = cvt_pk_bf16(v0[2], v0[3]); w.z = cvt_pk_bf16(v1[0], v1[1]); w.w = cvt_pk_bf16(v1[2], v1[3]);
                    *(u32x4*)(rowp + bj * HALF) = w; } }
    }
};
struct EpiResidB {
    static constexpr bool PERM = true, AFTER_DRAIN = false, PROBE_TWICE = false;
    bf16_t* H; int ldc; float s; unsigned long long* ssq; unsigned char* H8;
    __device__ __forceinline__ void operator()(const f32x4 (&acc)[2][2][4][2], const Unit& u, int wr, int wc, int fr, int fq) const {
        const int row0 = u.pm * BM + wr * 64 + fr, col0 = u.pn * BM + wc * 32 + 8 * fq;
#pragma unroll
        for (int ai = 0; ai < 2; ++ai) {
            u32x4 hv[4][2];
#pragma unroll
            for (int m = 0; m < 4; ++m)
#pragma unroll
                for (int bj = 0; bj < 2; ++bj) hv[m][bj] = *(const u32x4*)(H + (size_t)(row0 + ai * HALF + m * 16) * ldc + col0 + bj * HALF);
#pragma unroll
            for (int m = 0; m < 4; ++m) { const int row = row0 + ai * HALF + m * 16; bf16_t* rowp = H + (size_t)row * ldc + col0; float q = 0.f;
#pragma unroll
                for (int bj = 0; bj < 2; ++bj) { const u32x4 h = hv[m][bj]; const f32x4 a0 = acc[ai][bj][m][0] * s, a1 = acc[ai][bj][m][1] * s;
                    u32x4 w;
                    w.x = cvt_pk_bf16(__uint_as_float(h.x << 16) + a0[0], __uint_as_float(h.x & 0xffff0000u) + a0[1]);
                    w.y = cvt_pk_bf16(__uint_as_float(h.y << 16) + a0[2], __uint_as_float(h.y & 0xffff0000u) + a0[3]);
                    w.z = cvt_pk_bf16(__uint_as_float(h.z << 16) + a1[0], __uint_as_float(h.z & 0xffff0000u) + a1[1]);
                    w.w = cvt_pk_bf16(__uint_as_float(h.w << 16) + a1[2], __uint_as_float(h.w & 0xffff0000u) + a1[3]);
                    *(u32x4*)(rowp + bj * HALF) = w;
                    float f8[8];
#pragma unroll
                    for (int e = 0; e < 4; ++e) { const float lo = __uint_as_float(w[e] << 16), hi = __uint_as_float(w[e] & 0xffff0000u); q += lo * lo + hi * hi; f8[2 * e] = lo; f8[2 * e + 1] = hi; }
}
                q += __shfl_xor(q, 16); q += __shfl_xor(q, 32);
                if (fq == 0) atomicAdd(ssq + row, (unsigned long long)(q * 1048576.0f + 0.5f)); }
            asm volatile("" ::: "memory"); }
    }
};
struct EpiProj {
    static constexpr bool PERM = true, AFTER_DRAIN = false, PROBE_TWICE = false;
    bf16_t* O; int ldc; const float* rope_cos; const float* rope_sin; int rope_lo, rope_hi; const unsigned long long* ssq; float inv_k, eps;
    __device__ __forceinline__ void operator()(const f32x4 (&acc)[2][2][4][2], const Unit& u, int wr, int wc, int fr, int fq) const {
        const int row0 = u.pm * BM + wr * 64 + fr, col0 = u.pn * BM + wc * 32 + 8 * fq;
        const bool do_rope = (u.pn >= rope_lo) && (u.pn < rope_hi) && (wc == 0);
        float rsd[2][4];
#pragma unroll
        for (int ai = 0; ai < 2; ++ai)
#pragma unroll
            for (int m = 0; m < 4; ++m) rsd[ai][m] = __builtin_amdgcn_rsqf((float)(unsigned)(ssq[row0 + ai * HALF + m * 16] >> 12) * (inv_k * 4096.0f) + eps);
#pragma unroll
        for (int ai = 0; ai < 2; ++ai)
#pragma unroll
          for (int mh = 0; mh < 2; ++mh) {
            f32x4 c0[2], c1[2], s0[2], s1[2];
            if (do_rope) {
#pragma unroll
                for (int mm = 0; mm < 2; ++mm) { const int pos = (row0 + ai * HALF + (2 * mh + mm) * 16) & 2047, i0 = (fq & 1) * 8;
                    c0[mm] = *(const f32x4*)(rope_cos + pos * 16 + i0); c1[mm] = *(const f32x4*)(rope_cos + pos * 16 + i0 + 4);
                    s0[mm] = *(const f32x4*)(rope_sin + pos * 16 + i0); s1[mm] = *(const f32x4*)(rope_sin + pos * 16 + i0 + 4);
                    if (fq < 2) { s0[mm] = -s0[mm]; s1[mm] = -s1[mm]; } } }
#pragma unroll
            for (int mm = 0; mm < 2; ++mm) { const int m = 2 * mh + mm; const int row = row0 + ai * HALF + m * 16; bf16_t* rowp = O + (size_t)row * ldc + col0;
#pragma unroll
                for (int bj = 0; bj < 2; ++bj) { f32x4 v0 = acc[ai][bj][m][0] * rsd[ai][m], v1 = acc[ai][bj][m][1] * rsd[ai][m];
                    if (do_rope) { f32x4 p0, p1;
#pragma unroll
                        for (int j = 0; j < 4; ++j) { p0[j] = __shfl_xor(v0[j], 32); p1[j] = __shfl_xor(v1[j], 32); }
                        v0 = v0 * c0[mm] + p0 * s0[mm]; v1 = v1 * c1[mm] + p1 * s1[mm]; }
                    u32x4 w; w.x = cvt_pk_bf16(v0[0], v0[1]); w.y = cvt_pk_bf16(v0[2], v0[3]); w.z = cvt_pk_bf16(v1[0], v1[1]); w.w = cvt_pk_bf16(v1[2], v1[3]);
                    *(u32x4*)(rowp + bj * HALF) = w; } }
            asm volatile("" ::: "memory"); }
    }
};

template <class Epi, class Sched, bool ALIGN_EPI = false, bool SP2 = false, bool F8 = false, bool I8 = false, bool TM = false>
__device__ __forceinline__ void gemm_phase(PG8_LAS unsigned char* lds, const Gemm g, const Sched& S, const Epi& E) {
    int tid_ = threadIdx.x; asm volatile("" : "+v"(tid_));
    const int tid = tid_, wid = __builtin_amdgcn_readfirstlane(tid >> 6), lane = tid & 63, wr = wid >> 2, wc = wid & 3, fr = lane & 15, fq = lane >> 4;
    const int K = g.K, nt = K / BK;
    unsigned voffA[2], voffB[2];
#pragma unroll
    for (int i = 0; i < 2; ++i) { int R, C; stage_rc(tid * 16 + i * 8192, R, C); const int Rb = Epi::PERM ? ((R & ~31) + perm32(R & 31)) : R;
        voffA[i] = TM ? (unsigned)(R * 128 + C * 2) : (unsigned)(R * K + C) * 2u; voffB[i] = TM ? (unsigned)(Rb * 128 + C * 2) : (unsigned)(Rb * K + C) * 2u; }
    const size_t kstep = TM ? (size_t)32768 : (size_t)(BK * 2);
    const size_t hstep = TM ? (size_t)16384 : (size_t)HALF * K * 2;
    const size_t tstep = TM ? (size_t)nt * 32768 : 2 * hstep;
    const unsigned ldsw = (unsigned)wid * 1024u;
    const int aoff = lds_byte(wr * 64 + fr, fq * 8), boff = lds_byte(wc * 32 + fr, fq * 8);
#define PG8_SA(b, h) (((b) * 2 + (h)) * HTB)
#define PG8_SB(b, h) ((4 + (b) * 2 + (h)) * HTB)
#define PG8_STAGE(bufoff, gbase, voff) do { _Pragma("unroll") for (int _i = 0; _i < 2; ++_i) \
        __builtin_amdgcn_global_load_lds((const unsigned*)((const char*)(gbase) + (voff)[_i]), (PG8_LAS unsigned*)(lds + (bufoff) + ldsw + _i * 8192), 16, 0, 0); } while (0)
#define PG8_LDA(dst, b, h) do { if constexpr (F8) { _Pragma("unroll") for (int m = 0; m < 4; ++m) dst##8[m] = PG8_CAT(*(const PG8_LAS bf16x8*)(lds + PG8_SA(b, h) + aoff + m * 2048), *(const PG8_LAS bf16x8*)(lds + PG8_SA(b, h) + aoff + m * 2048 + 1024)); } \
        else { _Pragma("unroll") for (int m = 0; m < 4; ++m) _Pragma("unroll") for (int k = 0; k < 2; ++k) dst[m][k] = *(const PG8_LAS bf16x8*)(lds + PG8_SA(b, h) + aoff + m * 2048 + k * 1024); } } while (0)
#define PG8_LDB(dst, b, h) do { if constexpr (F8) { _Pragma("unroll") for (int n = 0; n < 2; ++n) dst##8[n] = PG8_CAT(*(const PG8_LAS bf16x8*)(lds + PG8_SB(b, h) + boff + n * 2048), *(const PG8_LAS bf16x8*)(lds + PG8_SB(b, h) + boff + n * 2048 + 1024)); } \
        else { _Pragma("unroll") for (int n = 0; n < 2; ++n) _Pragma("unroll") for (int k = 0; k < 2; ++k) dst[n][k] = *(const PG8_LAS bf16x8*)(lds + PG8_SB(b, h) + boff + n * 2048 + k * 1024); } } while (0)
    typedef int pg8_v4i __attribute__((ext_vector_type(4))); typedef int pg8_v8i __attribute__((ext_vector_type(8)));
#define PG8_CAT(x0, x1) __builtin_shufflevector(__builtin_bit_cast(pg8_v4i, x0), __builtin_bit_cast(pg8_v4i, x1), 0, 1, 2, 3, 4, 5, 6, 7)
#define PG8_MMA(ai, bj, At, Bt) do { __builtin_amdgcn_s_setprio(1); \
        if constexpr (F8) { _Pragma("unroll") for (int m = 0; m < 4; ++m) _Pragma("unroll") for (int n = 0; n < 2; ++n) \
            asm volatile("v_mfma_scale_f32_16x16x128_f8f6f4 %0, %1, %2, %0, %3, %3 op_sel_hi:[0,0,0]" : "+v"(acc[ai][bj][m][n]) : "v"(Bt##8[n]), "v"(At##8[m]), "v"(f8_scale)); } \
        else if constexpr (I8) { _Pragma("unroll") for (int m = 0; m < 4; ++m) _Pragma("unroll") for (int n = 0; n < 2; ++n) _Pragma("unroll") for (int k = 0; k < 2; ++k) \
            acc[ai][bj][m][n] = __builtin_bit_cast(f32x4, __builtin_amdgcn_mfma_i32_16x16x64_i8(__builtin_bit_cast(pg8_v4i, Bt[n][k]), __builtin_bit_cast(pg8_v4i, At[m][k]), __builtin_bit_cast(pg8_v4i, acc[ai][bj][m][n]), 0, 0, 0)); } \
        else { _Pragma("unroll") for (int m = 0; m < 4; ++m) _Pragma("unroll") for (int n = 0; n < 2; ++n) _Pragma("unroll") for (int k = 0; k < 2; ++k) \
            acc[ai][bj][m][n] = __builtin_amdgcn_mfma_f32_16x16x32_bf16(Bt[n][k], At[m][k], acc[ai][bj][m][n], 0, 0, 0); } \
        __builtin_amdgcn_s_setprio(0); } while (0)
#define PG8_WAIT_V(n) asm volatile("s_waitcnt vmcnt(" #n ")" ::: "memory")
#define PG8_WAIT_L(n) asm volatile("s_waitcnt lgkmcnt(" #n ")" ::: "memory")
#define PG8_BAR __builtin_amdgcn_s_barrier()
#define PG8_SCHED __builtin_amdgcn_sched_barrier(0)
    Unit cur, nxt; int ui = 0;
    if (!S.next(0, cur)) return;
    f32x4 acc[2][2][4][2];
#pragma unroll
    for (int a = 0; a < 2; ++a)
#pragma unroll
        for (int b = 0; b < 2; ++b)
#pragma unroll
            for (int m = 0; m < 4; ++m)
#pragma unroll
                for (int n = 0; n < 2; ++n) acc[a][b][m][n] = (f32x4){0.f, 0.f, 0.f, 0.f};
    const int f8_scale = 0x7F7F7F7F;
    bf16x8 At[4][2], B0[2][2], B1[2][2]; pg8_v8i At8[4], B08[2], B18[2];
    const char* cA = (const char*)g.A + (size_t)cur.pm * tstep; const char* cB = (const char*)g.Bt + (size_t)cur.pn * tstep;
    S.a_ready(cur);
    if constexpr (SP2) {
        PG8_STAGE(PG8_SB(0, 0), cB, voffB); PG8_STAGE(PG8_SB(0, 1), cB + hstep, voffB); PG8_STAGE(PG8_SA(0, 0), cA, voffA); PG8_STAGE(PG8_SA(0, 1), cA + hstep, voffA);
        if (wr == 1) PG8_BAR;
        PG8_WAIT_V(2); PG8_BAR;
        PG8_STAGE(PG8_SB(1, 0), cB + kstep, voffB); PG8_STAGE(PG8_SA(1, 0), cA + kstep, voffA); PG8_STAGE(PG8_SB(1, 1), cB + hstep + kstep, voffB);
        PG8_WAIT_V(6); PG8_BAR;
    } else {
        PG8_STAGE(PG8_SB(0, 0), cB, voffB); PG8_STAGE(PG8_SA(0, 0), cA, voffA); PG8_STAGE(PG8_SB(0, 1), cB + hstep, voffB); PG8_STAGE(PG8_SA(0, 1), cA + hstep, voffA);
        if (wr == 1) PG8_BAR;
        PG8_WAIT_V(4); PG8_BAR;
        PG8_STAGE(PG8_SB(1, 0), cB + kstep, voffB); PG8_STAGE(PG8_SA(1, 0), cA + kstep, voffA); PG8_STAGE(PG8_SB(1, 1), cB + hstep + kstep, voffB);
        PG8_WAIT_V(6); PG8_BAR;
    }
    for (;;) {
        const bool has_next = S.next(ui + 1, nxt);
        const char* nA = has_next ? (const char*)g.A + (size_t)nxt.pm * tstep : cA; const char* nB = has_next ? (const char*)g.Bt + (size_t)nxt.pn * tstep : cB;
        for (int t = 0; t < nt; t += 2) {
            const bool last = (t == nt - 2);
            const char* a1 = cA + (size_t)(t + 1) * kstep;
            const char* a2 = last ? nA : cA + (size_t)(t + 2) * kstep; const char* b2 = last ? nB : cB + (size_t)(t + 2) * kstep;
            const char* a3 = a2 + kstep; const char* b3 = b2 + kstep;
            if (last && has_next) S.a_ready(nxt);
            if constexpr (SP2) {
            PG8_LDB(B0, 0, 0); PG8_LDB(B1, 0, 1); PG8_SCHED; PG8_LDA(At, 0, 0); PG8_STAGE(PG8_SA(1, 1), a1 + hstep, voffA);
            PG8_WAIT_V(8); PG8_WAIT_L(0); PG8_BAR; PG8_MMA(0, 0, At, B0); PG8_MMA(0, 1, At, B1); PG8_BAR; PG8_SCHED;
            PG8_LDA(At, 0, 1); PG8_STAGE(PG8_SB(0, 0), b2, voffB); PG8_STAGE(PG8_SB(0, 1), b2 + hstep, voffB); PG8_STAGE(PG8_SA(0, 0), a2, voffA);
            PG8_WAIT_V(8); PG8_WAIT_L(0); PG8_BAR; PG8_MMA(1, 0, At, B0); PG8_MMA(1, 1, At, B1); PG8_BAR; PG8_SCHED;
            PG8_LDB(B0, 1, 0); PG8_LDB(B1, 1, 1); PG8_SCHED; PG8_LDA(At, 1, 0); PG8_STAGE(PG8_SA(0, 1), a2 + hstep, voffA);
            PG8_WAIT_V(8); PG8_WAIT_L(0); PG8_BAR; PG8_MMA(0, 0, At, B0); PG8_MMA(0, 1, At, B1); PG8_BAR; PG8_SCHED;
            PG8_LDA(At, 1, 1); PG8_STAGE(PG8_SB(1, 0), b3, voffB); PG8_STAGE(PG8_SB(1, 1), b3 + hstep, voffB); PG8_STAGE(PG8_SA(1, 0), a3, voffA);
            PG8_WAIT_V(8); PG8_WAIT_L(0); PG8_BAR; PG8_MMA(1, 0, At, B0); PG8_MMA(1, 1, At, B1); PG8_BAR; PG8_SCHED;
            } else {
            PG8_LDB(B0, 0, 0); PG8_SCHED; PG8_LDA(At, 0, 0); PG8_STAGE(PG8_SA(1, 1), a1 + hstep, voffA);
            PG8_WAIT_L(8); PG8_BAR; PG8_WAIT_L(0); PG8_MMA(0, 0, At, B0); PG8_BAR; PG8_SCHED;
            PG8_LDB(B1, 0, 1); PG8_STAGE(PG8_SB(0, 0), b2, voffB);
            PG8_BAR; PG8_WAIT_L(0); PG8_MMA(0, 1, At, B1); PG8_BAR;
            PG8_LDA(At, 0, 1); PG8_STAGE(PG8_SA(0, 0), a2, voffA);
            PG8_BAR; PG8_WAIT_L(0); PG8_MMA(1, 0, At, B0); PG8_BAR; PG8_SCHED;
            PG8_STAGE(PG8_SB(0, 1), b2 + hstep, voffB);
            PG8_WAIT_V(6); PG8_BAR; PG8_MMA(1, 1, At, B1); PG8_BAR;
            PG8_LDB(B0, 1, 0); PG8_SCHED; PG8_LDA(At, 1, 0); PG8_STAGE(PG8_SA(0, 1), a2 + hstep, voffA);
            PG8_WAIT_L(8); PG8_BAR; PG8_WAIT_L(0); PG8_MMA(0, 0, At, B0); PG8_BAR; PG8_SCHED;
            PG8_LDB(B1, 1, 1); PG8_STAGE(PG8_SB(1, 0), b3, voffB);
            PG8_BAR; PG8_WAIT_L(0); PG8_MMA(0, 1, At, B1); PG8_BAR;
            PG8_LDA(At, 1, 1); PG8_STAGE(PG8_SA(1, 0), a3, voffA);
            PG8_BAR; PG8_WAIT_L(0); PG8_MMA(1, 0, At, B0); PG8_BAR; PG8_SCHED;
            PG8_STAGE(PG8_SB(1, 1), b3 + hstep, voffB);
            PG8_WAIT_V(6); PG8_BAR; PG8_MMA(1, 1, At, B1); PG8_BAR;
            }
        }
        if constexpr (F8) asm volatile("s_nop 15\n\ts_nop 15" ::: "memory");
        if constexpr (ALIGN_EPI) { if (wr == 0) PG8_BAR; }
        if constexpr (!Epi::AFTER_DRAIN) { E(acc, cur, wr, wc, fr, fq);
#ifdef PROBE_EPI2
            if constexpr (Epi::PROBE_TWICE) { asm volatile("" ::: "memory"); E(acc, cur, wr, wc, fr, fq); }
#endif
            S.done(cur); }
        if (!has_next) break;
#pragma unroll
        for (int a = 0; a < 2; ++a)
#pragma unroll
            for (int b = 0; b < 2; ++b)
#pragma unroll
                for (int m = 0; m < 4; ++m)
#pragma unroll
                    for (int n = 0; n < 2; ++n) acc[a][b][m][n] = (f32x4){0.f, 0.f, 0.f, 0.f};
        cur = nxt; cA = nA; cB = nB; ++ui;
        if constexpr (ALIGN_EPI) { if (wr == 1) PG8_BAR; }
    }
    PG8_WAIT_V(0);
    if constexpr (!ALIGN_EPI) { if (wr == 0) PG8_BAR; }
    PG8_BAR;
    if constexpr (Epi::AFTER_DRAIN) { E.fused(acc, cur, wr, wc, fr, fq, lds, wid, lane); S.done(cur); }
#undef PG8_SA
#undef PG8_SB
#undef PG8_STAGE
#undef PG8_LDA
#undef PG8_LDB
#undef PG8_MMA
#undef PG8_CAT
#undef PG8_WAIT_V
#undef PG8_WAIT_L
#undef PG8_BAR
#undef PG8_SCHED
}
}
typedef float f32x2 __attribute__((ext_vector_type(2)));
constexpr int NWAVES = 8;
constexpr int BATCH = 8, SEQ = 2048, M = BATCH * SEQ, D = 4096, FF = 11008, NUP = 2 * FF, NIN = 11264, NIN_SRC = 11272, DEPTH = 2;
constexpr int DL = 1024, DFX = 1024, DDL = 2048, NFX = 8, NDL = 16, HD = 128;
constexpr int C_XA = 0, C_GA = 1024, C_QF = 2048, C_KF = 3072, C_VF = 4096, C_QD = 5120, C_KD = 7168, C_VD = 9216;
constexpr int SRC_FF_COL = 5120;
constexpr float EPS = 1e-6f;
#ifndef I8_UP_MASK
#define I8_UP_MASK 0xF
#endif
#ifndef FP8_UP_MASK
#define FP8_UP_MASK 0x0
#endif
#ifndef FP8_DOWN_MASK
#define FP8_DOWN_MASK 0xE
#endif
constexpr float FP8_WMUL = 64.0f, FP8_WMUL_DOWN = 128.0f, FP8_ACT_MUL = 8.0f;
constexpr float ATT_SCALE = 0.08838834764831845f;

constexpr size_t MiB = 1u << 20;
constexpr size_t WS_CTL = 0, CTL_ZERO_BYTES = 1024 * 1024;
constexpr size_t WS_WMAX = 256 * 1024;
constexpr size_t WS_ROPE = 1 * MiB;
constexpr size_t WS_WFF = WS_ROPE + 256 * 1024;
constexpr size_t WS_WG = WS_ROPE + 512 * 1024;
constexpr size_t WS_LF = 3 * MiB;
constexpr size_t WS_SSQ = WS_LF + 512 * 1024;
constexpr size_t WS_W1T = 5 * MiB;
constexpr size_t WS_W2T = WS_W1T + (size_t)4 * NUP * D * 2;
constexpr size_t WS_WIN = WS_W2T + (size_t)4 * D * FF * 2;
constexpr size_t WS_WOUT = WS_WIN + (size_t)2 * NIN * D * 2;
constexpr size_t WS_A1 = WS_WOUT + (size_t)2 * D * D * 2;
constexpr size_t WS_R = WS_A1 + (size_t)M * D * 2;
constexpr size_t WS_ACT = WS_R;
constexpr size_t WS_PROJ = WS_R;
constexpr size_t WS_HL = WS_PROJ + (size_t)M * NIN * 2;
constexpr size_t WS_PP = WS_HL + (size_t)M * DL * 4;
constexpr size_t WS_YB = WS_PP + (size_t)M * DL * 4;
constexpr size_t WS_YCP = WS_YB + (size_t)M * DFX * 2;
constexpr size_t WS_LSE = WS_YCP + (size_t)3 * M * DDL * 2;
constexpr size_t WS_HB = WS_LSE + (size_t)3 * M * NDL * 4;
constexpr size_t WS_HB8 = WS_HB + (size_t)M * D * 2;
constexpr size_t WS_ASC = WS_HB8 + (size_t)M * D;
constexpr size_t WS_END = WS_ASC + (size_t)M * 4;
static_assert(WS_ACT + (size_t)M * FF * 2 <= WS_END && WS_SSQ + (size_t)7 * M * 8 <= WS_W1T && WS_WG + 1024 * 1024 <= WS_LF, "d_ws map");
constexpr int CW_TMO = 0, CW_CODE = 1;
constexpr int CW_BAR = 4096;
constexpr int MAX_LAUNCHES = 8;

constexpr int RING_OFF = 0, RING_BYTES = 131072;
constexpr int LDSCTL_OFF = RING_BYTES, MISC_OFF = LDSCTL_OFF + 320;
constexpr int QS_OFF = RING_BYTES + 1024;
constexpr int LDS_BYTES = 147456;
static_assert(MISC_OFF + 128 <= QS_OFF && QS_OFF + 8192 <= LDS_BYTES, "LDS map");

#define GAS __attribute__((address_space(1)))
#define LAS __attribute__((address_space(3)))
typedef unsigned short bf16;
typedef unsigned v4u __attribute__((ext_vector_type(4)));
typedef float f32x4 __attribute__((ext_vector_type(4)));
typedef short bf16x8 __attribute__((ext_vector_type(8)));
typedef GAS unsigned gu32;
typedef GAS unsigned long long gu64;
#define RLX_AGENT __ATOMIC_RELAXED, __HIP_MEMORY_SCOPE_AGENT
#define LDS_WAIT() asm volatile("s_waitcnt lgkmcnt(0)" ::: "memory")
#define VM_WAIT() asm volatile("s_waitcnt vmcnt(0)" ::: "memory")
__device__ __forceinline__ unsigned long long rt() { return __builtin_amdgcn_s_memrealtime(); }
__device__ __forceinline__ unsigned f2bf(float f) { unsigned u = __builtin_bit_cast(unsigned, f); return (u + 0x7fffu + ((u >> 16) & 1u)) >> 16; }
__device__ __forceinline__ unsigned pk2(float lo, float hi) { return f2bf(lo) | (f2bf(hi) << 16); }

#define XB_TMO      128
#define XB_XCNT(j)  (256  + 64 * (j))
#define XB_XSUB(j)  (1280 + 64 * (j))
#define XB_XGEN(j)  (2304 + 64 * (j))
#define XB_TOP      3328
#define XB_TOPGEN   3392
#define XCD_BAR_WORDS 3456
#define XB_SPIN_CAP (1u << 18)

__device__ __forceinline__ unsigned xb_ld(unsigned* p)              { return __hip_atomic_load(p, __ATOMIC_RELAXED, __HIP_MEMORY_SCOPE_AGENT); }
__device__ __forceinline__ unsigned xb_add(unsigned* p, unsigned v) { return __hip_atomic_fetch_add(p, v, __ATOMIC_RELAXED, __HIP_MEMORY_SCOPE_AGENT); }
__device__ __forceinline__ unsigned xb_xcc_id() { return (unsigned)__builtin_amdgcn_s_getreg((3 << 11) | 20) & 0xFu; }
#define XB_SPIN(cond, bar) do { unsigned _sp = 0; while (cond) { __builtin_amdgcn_s_sleep(1); \
    if ((++_sp & 255u) == 0u) { if (xb_ld(&(bar)[XB_TMO])) break; if (_sp > XB_SPIN_CAP) { atomicAdd(&(bar)[XB_TMO], 1u); break; } } } } while (0)

struct XcdBarrier {
    unsigned* bar; unsigned x;
    volatile LAS unsigned* st;
};

__device__ __forceinline__ XcdBarrier xcd_barrier_post(unsigned* bar, volatile LAS unsigned* st) {
    XcdBarrier b; b.bar = bar; b.x = xb_xcc_id(); b.st = st;
    if (threadIdx.x == 0) (void)xb_add(&bar[XB_XCNT(b.x)], 1u);
    return b;
}
__device__ __forceinline__ void xcd_barrier_complete(unsigned* bar, unsigned x, unsigned& nloc, unsigned& nx) {
    const unsigned G = gridDim.x * gridDim.y * gridDim.z;
    unsigned sum, cnt, mine, sp = 0u;
    for (;;) {
        sum = 0u; cnt = 0u; mine = 0u;
#pragma unroll
        for (unsigned j = 0; j < 16; ++j) { const unsigned c = xb_ld(&bar[XB_XCNT(j)]); sum += c; cnt += (c > 0u) ? 1u : 0u; mine = (j == x) ? c : mine; }
        if (sum == G) break;
        __builtin_amdgcn_s_sleep(1);
        if ((++sp & 255u) == 0u) { if (xb_ld(&bar[XB_TMO])) break; if (sp > XB_SPIN_CAP) { atomicAdd(&bar[XB_TMO], 1u); break; } }
    }
    nloc = mine > 0u ? mine : 1u; nx = cnt > 0u ? cnt : 1u;
}

__device__ __forceinline__ void xcd_barrier(const XcdBarrier& b) {
    asm volatile("s_waitcnt vmcnt(0)" ::: "memory");
    __syncthreads();
    if (threadIdx.x == 0) {
        unsigned* bar = b.bar;
        __builtin_amdgcn_s_waitcnt(0);
        unsigned nloc = b.st[0], nx = b.st[1];
        if (nloc == 0u) { xcd_barrier_complete(bar, b.x, nloc, nx); b.st[0] = nloc; b.st[1] = nx; }
        const unsigned old = xb_add(&bar[XB_XSUB(b.x)], 1u);
        const unsigned gen = old / nloc;
        if (old + 1u == (gen + 1u) * nloc) {
            __builtin_amdgcn_fence(__ATOMIC_RELEASE, "agent");
            asm volatile("s_waitcnt vmcnt(0)" ::: "memory");
            const unsigned og = xb_add(&bar[XB_TOP], 1u);
            const unsigned tg = og / nx;
            if (og + 1u == (tg + 1u) * nx) xb_add(&bar[XB_TOPGEN], 1u);
            else XB_SPIN(xb_ld(&bar[XB_TOPGEN]) == tg, bar);
            __builtin_amdgcn_fence(__ATOMIC_ACQUIRE, "agent");
            xb_add(&bar[XB_XGEN(b.x)], 1u);
            asm volatile("s_waitcnt vmcnt(0)" ::: "memory");
        } else {
            XB_SPIN(xb_ld(&bar[XB_XGEN(b.x)]) == gen, bar);
            __builtin_amdgcn_fence(__ATOMIC_ACQUIRE, "agent");
            asm volatile("s_waitcnt vmcnt(0)" ::: "memory");
        }
    }
    __syncthreads();
}
#ifndef ATT_PRIO1
#define ATT_PRIO1 ((void)0)
#define ATT_PRIO0 ((void)0)
#endif
namespace att {
typedef short bf16x8 __attribute__((ext_vector_type(8)));
typedef short s16x4 __attribute__((ext_vector_type(4)));
typedef float f32x16 __attribute__((ext_vector_type(16)));
typedef float f32x4 __attribute__((ext_vector_type(4)));
typedef unsigned u32x4 __attribute__((ext_vector_type(4)));
constexpr float SCALE = 0.08838834764831845f, THR = 8.f;
constexpr int NW = 8, QBLK = 32, KVBLK = 64, QB = 256, DH = 128;
constexpr int SHM_V = KVBLK * DH * 2, SHM_K = KVBLK * DH * 2;
constexpr int WS_OFF = 2 * SHM_V + 2 * SHM_K, KB_OFF = WS_OFF + NW * 64 * 4, ATT_LDS = KB_OFF + 2048 * 4;
#define KSWZ(row, colB) ((row) * 256 + ((colB) ^ (((row) & 7) << 4)))
#define SBAR() __builtin_amdgcn_sched_barrier(0)
__device__ __forceinline__ int v_st(int k, int c) { const int kk = (k & ~0xC) | ((k & 4) << 1) | ((k & 8) >> 1); return ((kk >> 3) * 4 + (c >> 5)) * 512 + ((kk & 7) * 32 + (c & 31)) * 2; }
__device__ __forceinline__ int v_rd_base(int lane) { return ((lane & 3) << 3) | (((lane >> 2) & 3) << 6) | (((lane >> 4) & 1) << 5) | (((lane >> 5) & 1) << 8); }
constexpr int v_rd_off(int d0, int ks, int half) { return d0 * 512 + ks * 4096 + half * 2048; }
__device__ __forceinline__ int crow(int r, int hi) { return (r & 3) + 8 * (r >> 2) + 4 * hi; }
__device__ __forceinline__ unsigned cvtpk(float lo, float hi) { unsigned r; asm volatile("v_cvt_pk_bf16_f32 %0, %1, %2" : "=v"(r) : "v"(lo), "v"(hi)); return r; }
__device__ __forceinline__ void mask_tile(f32x16& p0, f32x16& p1, int dq, unsigned W) {
    const float NEG = -__builtin_inff();
#pragma unroll
    for (int r = 0; r < 16; ++r) { const int c = (r & 3) + 8 * (r >> 2);
        if ((unsigned)(dq - c) >= W) p0[r] = NEG;
        if ((unsigned)(dq - c - 32) >= W) p1[r] = NEG; }
}
__device__ __forceinline__ void partialSM(f32x16& p0, f32x16& p1, float& m_reg, float& mn, float& alpha) {
    float pmax = p0[0];
#pragma unroll
    for (int r = 1; r < 16; ++r) pmax = fmaxf(pmax, p0[r]);
#pragma unroll
    for (int r = 0; r < 16; ++r) pmax = fmaxf(pmax, p1[r]);
    { auto rr = __builtin_amdgcn_permlane32_swap(__float_as_uint(pmax), __float_as_uint(pmax), false, false);
      pmax = fmaxf(__uint_as_float(rr[0]), __uint_as_float(rr[1])); }
    constexpr float C2 = 1.4426950408889634f * SCALE;
    if (__builtin_expect(__all((pmax - m_reg) * SCALE <= THR), 1)) { mn = m_reg; alpha = 1.f; }
    else { mn = fmaxf(m_reg, pmax); alpha = __builtin_amdgcn_exp2f((m_reg - mn) * C2); m_reg = mn; }
    const float mnL = -mn * C2;
#pragma unroll
    for (int r = 0; r < 16; ++r) p0[r] = fmaf(p0[r], C2, mnL);
#pragma unroll
    for (int r = 0; r < 16; ++r) p1[r] = fmaf(p1[r], C2, mnL);
#pragma unroll
    for (int r = 0; r < 16; ++r) p0[r] = __builtin_amdgcn_exp2f(p0[r]);
}
__device__ __forceinline__ void finishSM(f32x16& p0, f32x16& p1, float alpha, float& l_reg, bf16x8& pa0, bf16x8& pa1, bf16x8& pa2, bf16x8& pa3) {
#pragma unroll
    for (int r = 0; r < 16; ++r) p1[r] = __builtin_amdgcn_exp2f(p1[r]);
    float ps = 0;
#pragma unroll
    for (int r = 0; r < 16; ++r) ps += p0[r];
#pragma unroll
    for (int r = 0; r < 16; ++r) ps += p1[r];
    { auto rr = __builtin_amdgcn_permlane32_swap(__float_as_uint(ps), __float_as_uint(ps), false, false);
      ps = __uint_as_float(rr[0]) + __uint_as_float(rr[1]); }
    l_reg = l_reg * alpha + ps;
#define PK4(P, B_, OUT) do { unsigned a0 = cvtpk(P[B_+0], P[B_+1]), a1 = cvtpk(P[B_+2], P[B_+3]);                          \
        unsigned b0 = cvtpk(P[B_+4], P[B_+5]), b1 = cvtpk(P[B_+6], P[B_+7]);                                             \
        auto r0 = __builtin_amdgcn_permlane32_swap(a0, b0, false, false); auto r1 = __builtin_amdgcn_permlane32_swap(a1, b1, false, false); \
        u32x4 w = {r0[0], r1[0], r0[1], r1[1]}; OUT = *reinterpret_cast<bf16x8*>(&w); } while (0)
    PK4(p0, 0, pa0); PK4(p0, 8, pa1); PK4(p1, 0, pa2); PK4(p1, 8, pa3);
#undef PK4
}
template <int KB>
__device__ __forceinline__ void qkt(f32x16& p0, f32x16& p1, const char* K_lds, int r32, int hi, const bf16x8* qr, bool act) {
    if (!act) { const float NEG = -__builtin_inff();
#pragma unroll
        for (int r = 0; r < 16; ++r) { p0[r] = NEG; p1[r] = NEG; } return; }
    p0 = f32x16{}; p1 = f32x16{};
    const char* kb[4];
#pragma unroll
    for (int dd = 0; dd < 4; ++dd) kb[dd] = K_lds + KB * SHM_K + KSWZ(r32, (dd * 16 + hi * 8) * 2);
    ATT_PRIO1;
#pragma unroll
    for (int d0 = 0; d0 < 8; ++d0) { const char* a = kb[d0 & 3] + (d0 >> 2) * 128;
        bf16x8 b0 = *reinterpret_cast<const bf16x8*>(a);
        bf16x8 b1 = *reinterpret_cast<const bf16x8*>(a + 32 * 256);
        p0 = __builtin_amdgcn_mfma_f32_32x32x16_bf16(b0, qr[d0], p0, 0, 0, 0);
        p1 = __builtin_amdgcn_mfma_f32_32x32x16_bf16(b1, qr[d0], p1, 0, 0, 0); }
    ATT_PRIO0;
}
template <int VB>
__device__ __forceinline__ void pv_tile(f32x16* o, int vb0, bf16x8 pa0, bf16x8 pa1, bf16x8 pa2, bf16x8 pa3, bool act) {
    if (!act) return;
#define TRRD(dst, off) asm volatile("ds_read_b64_tr_b16 %0, %1 offset:%2" : "=&v"(dst) : "v"(vb0), "i"(off) : "memory")
#define PV_D0(d0) do { s16x4 l0, l1, l2, l3, h0, h1, h2, h3; constexpr int b_ = VB * SHM_V + v_rd_off(d0, 0, 0); \
        TRRD(l0, b_); TRRD(h0, b_ + 2048); TRRD(l1, b_ + 4096); TRRD(h1, b_ + 6144); TRRD(l2, b_ + 8192); TRRD(h2, b_ + 10240); TRRD(l3, b_ + 12288); TRRD(h3, b_ + 14336); \
        asm volatile("s_waitcnt lgkmcnt(0)" ::: "memory"); SBAR();   \
        o[d0] = __builtin_amdgcn_mfma_f32_32x32x16_bf16(pa0, (bf16x8){l0[0], l0[1], l0[2], l0[3], h0[0], h0[1], h0[2], h0[3]}, o[d0], 0, 0, 0);   \
        o[d0] = __builtin_amdgcn_mfma_f32_32x32x16_bf16(pa1, (bf16x8){l1[0], l1[1], l1[2], l1[3], h1[0], h1[1], h1[2], h1[3]}, o[d0], 0, 0, 0);   \
        o[d0] = __builtin_amdgcn_mfma_f32_32x32x16_bf16(pa2, (bf16x8){l2[0], l2[1], l2[2], l2[3], h2[0], h2[1], h2[2], h2[3]}, o[d0], 0, 0, 0);   \
        o[d0] = __builtin_amdgcn_mfma_f32_32x32x16_bf16(pa3, (bf16x8){l3[0], l3[1], l3[2], l3[3], h3[0], h3[1], h3[2], h3[3]}, o[d0], 0, 0, 0); } while (0)
    ATT_PRIO1; PV_D0(0); PV_D0(1); PV_D0(2); PV_D0(3); ATT_PRIO0;
#undef PV_D0
#undef TRRD
}
struct Blk {
    const unsigned short* Q; const unsigned short* K; const unsigned short* V; unsigned short* O; float* L;
    int qstride, kstride, ostride, lstride; int pair_off, opair_off, lpair_off;
    int P0, j_lo, NT, W, pair;
    const float* kbias;
};
template <bool BIAS>
__device__ __forceinline__ void attn_block(const Blk& B, char* lds) {
    int tz = threadIdx.x; asm volatile("" : "+v"(tz));
    const int tid = tz, wid = __builtin_amdgcn_readfirstlane(tid >> 6), lane = tid & 63, r32 = lane & 31, hi = lane >> 5;
    const int NT = B.NT, W = B.W, pair = B.pair, j_lo = B.j_lo;
    const int seq = pair ? (wid >> 2) : 0, wq = pair ? (wid & 3) : wid;
    const int qlo = pair ? seq * 1024 + wq * 32 : B.P0 + wid * 32, qm = qlo + r32 - 4 * hi;
    char* V_lds = lds; char* K_lds = lds + 2 * SHM_V;
    float* ws = (float*)(lds + WS_OFF) + wid * 64; float* li_l = ws, * al_l = ws + 32;
    const float* kbl = (const float*)(lds + KB_OFF);
    float m_reg = -1e30f, l_reg = 0; f32x16 o[4] = {};
    const int sr = tid >> 4, sc = (tid & 15) * 8, vst0 = v_st(sr, sc), vst1 = v_st(32 + sr, sc), kws = KSWZ(sr, sc * 2);
    const int vb0 = (int)(uintptr_t)V_lds + v_rd_base(lane);
    const unsigned short* Kh = B.K; const unsigned short* Vh = B.V; const int kstride = B.kstride;
    bf16x8 st_v0, st_v1, st_k0, st_k1;
#define KPOS(t) (pair ? ((t) >> 1) * 1024 + ((t) & 1) * 64 : (j_lo + (t)) * 64)
#define KOFF(t) (pair ? (size_t)((t) >> 1) * B.pair_off + (size_t)(((t) & 1) * 64) * kstride : (size_t)((j_lo + (t)) * 64) * kstride)
#define SLOAD_H(t) do { const size_t ko_ = KOFF(t) + (size_t)sr * kstride + sc; const size_t k32_ = (size_t)32 * kstride; \
        st_v0 = *(const bf16x8*)(Vh + ko_); st_v1 = *(const bf16x8*)(Vh + ko_ + k32_); st_k0 = *(const bf16x8*)(Kh + ko_); st_k1 = *(const bf16x8*)(Kh + ko_ + k32_); } while (0)
#define SWRITE_H(bf) do { *(bf16x8*)(V_lds + (bf) * SHM_V + vst0) = st_v0; *(bf16x8*)(V_lds + (bf) * SHM_V + vst1) = st_v1; \
        *(bf16x8*)(K_lds + (bf) * SHM_K + kws) = st_k0; *(bf16x8*)(K_lds + (bf) * SHM_K + kws + 32 * 256) = st_k1; } while (0)
#define VMW() asm volatile("s_waitcnt vmcnt(0)" ::: "memory")
#define RESC(a) do { if (__any((a) < 1.f)) { if (hi == 0) al_l[r32] = (a); asm volatile("s_waitcnt lgkmcnt(0)" ::: "memory");              \
                     for (int d_ = 0; d_ < 4; ++d_) for (int r = 0; r < 16; ++r) o[d_][r] *= al_l[crow(r, hi)]; } } while (0)
#define ACT(t) (KPOS(t) <= qlo + QBLK - 1 && KPOS(t) + KVBLK - 1 >= qlo - W + 1)
#define MASKT(P0_, P1_, t) do { const int kb_ = KPOS(t); if (ACT(t)) { \
        if (BIAS) { const float* bp_ = kbl + kb_ + 4 * hi; _Pragma("unroll") for (int g_ = 0; g_ < 4; ++g_) { const f32x4 b0_ = *(const f32x4*)(bp_ + 8 * g_), b1_ = *(const f32x4*)(bp_ + 32 + 8 * g_); \
            _Pragma("unroll") for (int j_ = 0; j_ < 4; ++j_) { P0_[4 * g_ + j_] += b0_[j_]; P1_[4 * g_ + j_] += b1_[j_]; } } } \
        if (kb_ + KVBLK - 1 > qlo || kb_ <= qlo + QBLK - 1 - W) mask_tile(P0_, P1_, qm - kb_, (unsigned)W); } } while (0)
    bf16x8 qr[8];
    { const unsigned short* qrow = B.Q + (size_t)seq * B.pair_off + (size_t)(wq * 32 + r32) * B.qstride;
#pragma unroll
      for (int d0 = 0; d0 < 8; ++d0) qr[d0] = *(const bf16x8*)(qrow + d0 * 16 + hi * 8); }
    f32x16 pA0, pA1, pB0, pB1; float mnA, mnB, alA, alB; bf16x8 pa0, pa1, pa2, pa3;
    SLOAD_H(0); VMW(); SWRITE_H(0); SBAR();
    if (NT > 1) SLOAD_H(1);
    __syncthreads();
    SBAR(); qkt<0>(pA0, pA1, K_lds, r32, hi, qr, ACT(0));
    MASKT(pA0, pA1, 0); partialSM(pA0, pA1, m_reg, mnA, alA);
    if (NT > 1) { VMW(); SWRITE_H(1); }
    __syncthreads();
#define HALF_STEP(PX0, PX1, mnX, alX, PY0, PY1, alY, t, KB, VB, SB) do {                                                      \
        SBAR(); qkt<KB>(PX0, PX1, K_lds, r32, hi, qr, ACT(t));                                                                \
        finishSM(PY0, PY1, alY, l_reg, pa0, pa1, pa2, pa3); SBAR();                                                           \
        if ((t) + 1 < NT) { SLOAD_H((t) + 1); SBAR(); }                                                                       \
        pv_tile<VB>(o, vb0, pa0, pa1, pa2, pa3, ACT((t) - 1)); MASKT(PX0, PX1, (t)); partialSM(PX0, PX1, m_reg, mnX, alX);    \
        __syncthreads();                                                                                                      \
        if ((t) + 1 < NT) { VMW(); SWRITE_H(SB); }                                                                            \
        RESC(alX); __syncthreads(); } while (0)
    for (int t = 1; t + 1 < NT; t += 2) {
        HALF_STEP(pB0, pB1, mnB, alB, pA0, pA1, alA, t, 1, 0, 0);
        HALF_STEP(pA0, pA1, mnA, alA, pB0, pB1, alB, t + 1, 0, 1, 1);
    }
    const bool even = (NT & 1) == 0;
    if (even) { SBAR(); qkt<1>(pB0, pB1, K_lds, r32, hi, qr, ACT(NT - 1)); SBAR(); }
    finishSM(pA0, pA1, alA, l_reg, pa0, pa1, pa2, pa3); SBAR();
    pv_tile<0>(o, vb0, pa0, pa1, pa2, pa3, ACT(even ? NT - 2 : NT - 1));
    if (even) { MASKT(pB0, pB1, NT - 1); partialSM(pB0, pB1, m_reg, mnB, alB); __syncthreads(); RESC(alB);
        finishSM(pB0, pB1, alB, l_reg, pa0, pa1, pa2, pa3); SBAR(); pv_tile<1>(o, vb0, pa0, pa1, pa2, pa3, ACT(NT - 1)); }
    SBAR();
    if (hi == 0) li_l[r32] = l_reg; asm volatile("s_waitcnt lgkmcnt(0)" ::: "memory");
    float rli[16];
#pragma unroll
    for (int r = 0; r < 16; ++r) rli[r] = __builtin_amdgcn_rcpf(li_l[crow(r, hi)]);
    unsigned short* Ow = B.O + (size_t)seq * B.opair_off + (size_t)(wq * 32) * B.ostride;
#pragma unroll
    for (int r = 0; r < 16; ++r) { const int orow = crow(r, hi);
#pragma unroll
        for (int d0 = 0; d0 < 4; ++d0) { const float v = o[d0][r] * rli[r]; const float vn = __shfl_xor(v, 1);
            if ((r32 & 1) == 0) *(unsigned*)(Ow + (size_t)orow * B.ostride + d0 * 32 + r32) = cvtpk(v, vn); } }
    if (B.L != nullptr && hi == 0) B.L[(size_t)seq * B.lpair_off + (size_t)(wq * 32 + r32) * B.lstride] = m_reg * SCALE + __logf(l_reg);
    __syncthreads();
#undef KPOS
#undef KOFF
#undef SLOAD_H
#undef SWRITE_H
#undef VMW
#undef RESC
#undef ACT
#undef MASKT
#undef HALF_STEP
}
#undef KSWZ
#undef SBAR
}
static_assert((CW_BAR + MAX_LAUNCHES * XCD_BAR_WORDS) * 4 <= (int)CTL_ZERO_BYTES, "CTL words inside the memset region");

struct Frame {
    LAS unsigned char* lds;
    int tid, lane, wave;
    int vcu, G, bx;
};
__device__ __forceinline__ float wave_sum(float v) {
#pragma unroll
    for (int o = 1; o < 64; o <<= 1) v += __shfl_xor(v, o);
    return v;
}
__device__ __forceinline__ float wave_max(float v) {
#pragma unroll
    for (int o = 1; o < 64; o <<= 1) v = fmaxf(v, __shfl_xor(v, o));
    return v;
}
__device__ __forceinline__ float bf_lo(unsigned w) { return __builtin_bit_cast(float, w << 16); }
__device__ __forceinline__ float bf_hi(unsigned w) { return __builtin_bit_cast(float, w & 0xffff0000u); }
__device__ __forceinline__ float bf2f(bf16 b) { return __builtin_bit_cast(float, (unsigned)b << 16); }

__device__ __forceinline__ void transpose64(const float* __restrict__ W, int ldw, int src_col0, int k0, bf16* __restrict__ WT, int K, int dest_row0, LAS unsigned* scr, int lane, const float* __restrict__ kscale = nullptr, int tm_nt = 0) {
    const int q = lane & 15, r = lane >> 4;
#pragma unroll
    for (int p = 0; p < 8; ++p) { const int kr = 8 * p + 2 * r;
        f32x4 a = *(const f32x4*)(W + (size_t)(k0 + kr) * ldw + src_col0 + 4 * q);
        f32x4 b = *(const f32x4*)(W + (size_t)(k0 + kr + 1) * ldw + src_col0 + 4 * q);
        if (kscale != nullptr) { a = a * kscale[k0 + kr]; b = b * kscale[k0 + kr + 1]; }
        const int kp = 4 * p + r;
#pragma unroll
        for (int j = 0; j < 4; ++j) { unsigned w_ = pg8::cvt_pk_bf16(a[j], b[j]);
#ifdef PROBE_WTRUNC
            w_ = (w_ + PROBE_WTRUNC_ADD) & PROBE_WTRUNC_MASK;
#endif
            scr[(4 * q + j) * 33 + kp] = w_; } }
    LDS_WAIT(); asm volatile("" ::: "memory");
    const int c = lane & 7;
#pragma unroll
    for (int jj = 0; jj < 8; ++jj) { const int n = (lane >> 3) + 8 * jj; const LAS unsigned* s = scr + n * 33 + 4 * c;
        v4u o; o.x = s[0]; o.y = s[1]; o.z = s[2]; o.w = s[3];
        const int dn_ = dest_row0 + n;
        if (tm_nt) *(v4u*)((unsigned char*)WT + ((size_t)((dn_ >> 8) * tm_nt + (k0 >> 6)) * 256 + (dn_ & 255)) * 128 + 16 * c) = o;
        else *(v4u*)(WT + (size_t)dn_ * K + k0 + 8 * c) = o; }
    LDS_WAIT(); asm volatile("" ::: "memory");
}
struct Args { const float* in[22]; float* out; unsigned char* ws; int ph_lo, ph_hi, li, pad; };
__device__ __forceinline__ void transpose64_fp8(const float* __restrict__ W, int ldw, int src_col0, int k0, unsigned char* __restrict__ WT, int K, int dest_row0, LAS unsigned* scr, int lane, const float* __restrict__ kscale, float wmul, int tm_nt = 0) {
    const int q = lane & 15, r = lane >> 4;
#pragma unroll
    for (int p = 0; p < 4; ++p) { const int kr = 16 * p + 4 * r;
        f32x4 a[4];
#pragma unroll
        for (int i = 0; i < 4; ++i) { a[i] = *(const f32x4*)(W + (size_t)(k0 + kr + i) * ldw + src_col0 + 4 * q); a[i] = a[i] * ((kscale != nullptr ? kscale[k0 + kr + i] : 1.0f) * wmul); }
#pragma unroll
        for (int j = 0; j < 4; ++j) { int w_ = 0; w_ = __builtin_amdgcn_cvt_pk_fp8_f32(a[0][j], a[1][j], w_, false); w_ = __builtin_amdgcn_cvt_pk_fp8_f32(a[2][j], a[3][j], w_, true);
            scr[(4 * q + j) * 17 + 4 * p + r] = (unsigned)w_; } }
    LDS_WAIT(); asm volatile("" ::: "memory");
    const int c = lane & 3;
#pragma unroll
    for (int jj = 0; jj < 4; ++jj) { const int n = (lane >> 2) + 16 * jj; const LAS unsigned* s = scr + n * 17 + 4 * c;
        v4u o; o.x = s[0]; o.y = s[1]; o.z = s[2]; o.w = s[3];
        const int dn_ = dest_row0 + n;
        if (tm_nt) *(v4u*)(WT + ((size_t)((dn_ >> 8) * tm_nt + (k0 >> 7)) * 256 + (dn_ & 255)) * 128 + (k0 & 127) + 16 * c) = o;
        else *(v4u*)(WT + (size_t)dn_ * K + k0 + 16 * c) = o; }
    LDS_WAIT(); asm volatile("" ::: "memory");
}
__device__ __forceinline__ void transpose64_i8(const float* __restrict__ W, int ldw, int src_col0, int k0, unsigned char* __restrict__ WT, int K, int dest_row0, LAS unsigned* scr, int lane, const float* __restrict__ kscale, const unsigned* __restrict__ cmax, int tm_nt = 0) {
    const int q = lane & 15, r = lane >> 4;
    f32x4 inv;
    { const v4u mx = *(const v4u*)(cmax + dest_row0 + 4 * q);
#pragma unroll
      for (int j = 0; j < 4; ++j) inv[j] = 127.0f / fmaxf(__uint_as_float(mx[j]), 1e-30f); }
#pragma unroll
    for (int p = 0; p < 4; ++p) { const int kr = 16 * p + 4 * r;
        f32x4 a[4];
#pragma unroll
        for (int i = 0; i < 4; ++i) { a[i] = *(const f32x4*)(W + (size_t)(k0 + kr + i) * ldw + src_col0 + 4 * q); a[i] = a[i] * (kscale != nullptr ? kscale[k0 + kr + i] : 1.0f) * inv; }
#pragma unroll
        for (int j = 0; j < 4; ++j) { unsigned w_ = 0u;
#pragma unroll
            for (int i = 0; i < 4; ++i) { int qv = __float2int_rn(a[i][j]); qv = qv < -127 ? -127 : (qv > 127 ? 127 : qv); w_ |= ((unsigned)qv & 0xffu) << (8 * i); }
            scr[(4 * q + j) * 17 + 4 * p + r] = w_; } }
    LDS_WAIT(); asm volatile("" ::: "memory");
    const int c = lane & 3;
#pragma unroll
    for (int jj = 0; jj < 4; ++jj) { const int n = (lane >> 2) + 16 * jj; const LAS unsigned* s = scr + n * 17 + 4 * c;
        v4u o; o.x = s[0]; o.y = s[1]; o.z = s[2]; o.w = s[3];
        const int dn_ = dest_row0 + n;
        if (tm_nt) *(v4u*)(WT + ((size_t)((dn_ >> 8) * tm_nt + (k0 >> 7)) * 256 + (dn_ & 255)) * 128 + (k0 & 127) + 16 * c) = o;
        else *(v4u*)(WT + (size_t)dn_ * K + k0 + 16 * c) = o; }
    LDS_WAIT(); asm volatile("" ::: "memory");
}
__device__ __forceinline__ void colmax_job(const Frame& F, const float* __restrict__ W, int ldw, int K, int Nsrc, const float* __restrict__ kscale, unsigned* __restrict__ cmax) {
    const int gw = F.vcu * NWAVES + F.wave, NGW = F.G * NWAVES;
    const int ncg = Nsrc / 256, nkc = K / 128, ntasks = ncg * nkc;
    for (int t = gw; t < ntasks; t += NGW) { const int kc = t / ncg, cg = t - kc * ncg, c = cg * 256 + 4 * F.lane;
        f32x4 mx = {0.f, 0.f, 0.f, 0.f}; const float* wp = W + (size_t)(kc * 128) * ldw + c; const float* ks = kscale + kc * 128;
#pragma unroll 16
        for (int k = 0; k < 128; ++k) { const f32x4 v = *(const f32x4*)(wp + (size_t)k * ldw) * ks[k];
            mx.x = fmaxf(mx.x, fabsf(v.x)); mx.y = fmaxf(mx.y, fabsf(v.y)); mx.z = fmaxf(mx.z, fabsf(v.z)); mx.w = fmaxf(mx.w, fabsf(v.w)); }
        const int half = c >= FF ? 1 : 0, cc = c - half * FF, dest = (cc >> 7) * 256 + half * 128 + (cc & 127);
#pragma unroll
        for (int j = 0; j < 4; ++j) atomicMax(cmax + dest + j, __float_as_uint(mx[j])); }
}
__device__ __forceinline__ void transpose_job(const Frame& F, const float* W, int ldw, int K, int Ndest, bf16* WT, int kind, const float* kscale = nullptr, int gw_ = -1, int ngw_ = 0, float f8mul = 0.f, const unsigned* cmax = nullptr, int it_lo = 0, int it_hi = -1, int tm = 0, int rev = 0) {
    LAS unsigned* scr = (LAS unsigned*)(F.lds + RING_OFF) + F.wave * (64 * 33);
    const int gw = gw_ >= 0 ? gw_ : F.vcu * NWAVES + F.wave, NGW = gw_ >= 0 ? ngw_ : F.G * NWAVES;
    const int nnb = Ndest / 64, nitems = (K / 64) * nnb;
    const int it_end = it_hi < 0 ? nitems : it_hi;
    for (int it0 = it_lo + gw; it0 < it_end; it0 += NGW) { const int it = rev ? it_lo + it_end - 1 - it0 : it0;
        const int kb = it / nnb, nb = it - kb * nnb, n0 = nb * 64;
        int src;
        if (kind == 0) { const int pn = n0 >> 8, within = n0 & 255; src = (within >> 7) * FF + pn * 128 + (within & 127); }
        else if (kind == 2) src = n0 < SRC_FF_COL ? n0 : n0 + 8;
        else src = n0;
        if (cmax != nullptr) transpose64_i8(W, ldw, src, kb * 64, (unsigned char*)WT, K, n0, scr, F.lane, kscale, cmax, tm ? K / 128 : 0);
        else if (f8mul != 0.f) transpose64_fp8(W, ldw, src, kb * 64, (unsigned char*)WT, K, n0, scr, F.lane, kscale, f8mul, tm ? K / 128 : 0);
        else transpose64(W, ldw, src, kb * 64, WT, K, n0, scr, F.lane, kscale, tm ? K / 64 : 0);
    }
}
__device__ __forceinline__ void p0_prologue(const Frame& F, const Args& P) {
    unsigned char* ws = P.ws;
    for (int fi = 0; fi < 4; ++fi) { const int l = fi >> 1, wh = fi & 1;
        if (!((I8_UP_MASK >> fi) & 1)) transpose_job(F, P.in[wh ? 19 : 2] + (size_t)l * D * NUP, NUP, D, NUP, (bf16*)(ws + WS_W1T) + (size_t)fi * NUP * D, 0, P.in[wh ? 18 : 1] + (size_t)l * D, -1, 0, ((FP8_UP_MASK >> fi) & 1) ? FP8_WMUL : 0.f,
                      ((I8_UP_MASK >> fi) & 1) ? (const unsigned*)(ws + WS_WMAX) + (size_t)fi * NUP : nullptr, 0, -1, ((I8_UP_MASK >> fi) & 1) ? 1 : 0);
          }
    for (int l = 0; l < DEPTH; ++l) {
        transpose_job(F, P.in[5] + (size_t)l * D * NIN_SRC, NIN_SRC, D, NIN, (bf16*)(ws + WS_WIN) + (size_t)l * NIN * D, 2, P.in[4] + (size_t)l * D);
        transpose_job(F, P.in[17] + (size_t)l * D * D, D, D, D, (bf16*)(ws + WS_WOUT) + (size_t)l * D * D, 1); }
    { LAS unsigned* scr = (LAS unsigned*)(F.lds + RING_OFF) + F.wave * (64 * 33); const int gw = F.vcu * NWAVES + F.wave, NGW = F.G * NWAVES;
      for (int it = gw; it < DEPTH * 2 * 8 * 4; it += NGW) { const int q = it & 3, mat = it >> 2, gg = mat & 7, gate = (mat >> 3) & 1, l = mat >> 4;
          const float* W = P.in[gate ? 10 : 8] + ((size_t)l * 8 + gg) * 128 * 128;
          transpose64(W, 128, (q & 1) * 64, (q >> 1) * 64, (bf16*)(ws + WS_WG) + (((size_t)l * 2 + gate) * 8 + gg) * 128 * 128, 128, (q & 1) * 64, scr, F.lane); } }
    const int gt = F.bx * (NWAVES * 64) + F.tid, NGT = F.G * NWAVES * 64;
    float* wff = (float*)(ws + WS_WFF);
    for (int i = gt; i < DEPTH * 8 * D; i += NGT) { const int l = i / (8 * D), j = (i / D) & 7, k = i % D;
        wff[i] = P.in[5][(size_t)l * D * NIN_SRC + (size_t)k * NIN_SRC + SRC_FF_COL + j] * P.in[4][(size_t)l * D + k]; }
    float* rc = (float*)(ws + WS_ROPE); float* rs = rc + SEQ * 16;
    for (int i = gt; i < SEQ * 16; i += NGT) { const int pos = i >> 4, fi = i & 15;
        const float inv = 1.0f / powf(500000.0f, (float)(2 * fi) / 32.0f); const float ang = (float)pos * inv;
        rc[i] = cosf(ang); rs[i] = sinf(ang); }
    unsigned long long* ssq = (unsigned long long*)(ws + WS_SSQ);
    for (int i = gt; i < 6 * M; i += NGT) ssq[M + i] = 0ull;
    { bf16* hb = (bf16*)(ws + WS_HB); const float* x = P.in[0]; const int gw = F.vcu * NWAVES + F.wave, NGW = F.G * NWAVES;
      unsigned char* hq = ws + WS_HB8; float* asc = (float*)(ws + WS_ASC);
      for (int row = gw; row < M; row += NGW) { const f32x4* xr = (const f32x4*)(x + (size_t)row * D) + F.lane; unsigned long long* o8 = (unsigned long long*)(hb + (size_t)row * D) + F.lane; float ss = 0.f, mx = 0.f;
          f32x4 r[16];
#pragma unroll
          for (int j = 0; j < 16; ++j) { const f32x4 v = xr[64 * j]; const unsigned w0 = pg8::cvt_pk_bf16(v.x, v.y), w1 = pg8::cvt_pk_bf16(v.z, v.w); o8[64 * j] = (unsigned long long)w0 | ((unsigned long long)w1 << 32);
              const float a = bf_lo(w0), b = bf_hi(w0), c = bf_lo(w1), d = bf_hi(w1); ss += (a * a + b * b) + (c * c + d * d); r[j] = (f32x4){a, b, c, d};
              mx = fmaxf(fmaxf(mx, fmaxf(fabsf(a), fabsf(b))), fmaxf(fabsf(c), fabsf(d))); }
          ss = wave_sum(ss); if (F.lane == 0) ssq[row] = (unsigned long long)(ss * 1048576.0f + 0.5f);
          if (I8_UP_MASK & 1) { mx = fmaxf(wave_max(mx), 1e-30f); const float inv = 127.0f / mx; unsigned char* qp = hq + ((size_t)(row >> 8) * (D / 128) * 256 + (row & 255)) * 128 + (size_t)(F.lane >> 5) * 32768 + ((4 * F.lane) & 127);
#pragma unroll
              for (int j = 0; j < 16; ++j) { unsigned w_ = 0u;
#pragma unroll
                  for (int e = 0; e < 4; ++e) { int qv = __float2int_rn(r[j][e] * inv); qv = qv < -127 ? -127 : (qv > 127 ? 127 : qv); w_ |= ((unsigned)qv & 0xffu) << (8 * e); }
                  *(unsigned*)(qp + (size_t)j * 65536) = w_; }
              if (F.lane == 0) asc[row] = mx * (1.0f / 127.0f); } } }
}

__device__ __forceinline__ void ff_rows(const Frame& F, const bf16* __restrict__ hb, const unsigned long long* __restrict__ ssq, const float* __restrict__ wff, const float* __restrict__ bff, float* __restrict__ lf) {
    LAS float* wl = (LAS float*)(F.lds + RING_OFF);
    for (int i = F.tid; i < 8 * D / 4; i += NWAVES * 64) ((LAS f32x4*)wl)[i] = ((const f32x4*)wff)[i];
    __syncthreads();
    const int gw = F.vcu * NWAVES + F.wave, NGW = F.G * NWAVES;
    for (int row = gw; row < M; row += 2 * NGW) {
        const int row1 = row + NGW < M ? row + NGW : row;
        const uint2* hr0 = (const uint2*)(hb + (size_t)row * D) + F.lane; const uint2* hr1 = (const uint2*)(hb + (size_t)row1 * D) + F.lane;
        uint2 w0[16], w1[16];
#pragma unroll
        for (int j = 0; j < 16; ++j) { w0[j] = hr0[64 * j]; w1[j] = hr1[64 * j]; }
        const float rstd0 = 1.0f / sqrtf((float)ssq[row] * (1.0f / (1048576.0f * D)) + EPS), rstd1 = 1.0f / sqrtf((float)ssq[row1] * (1.0f / (1048576.0f * D)) + EPS);
        float mine0 = 0.f, mine1 = 0.f;
#pragma unroll 1
        for (int h = 0; h < 8; ++h) { float a0 = 0.f, a1 = 0.f;
#pragma unroll
            for (int j = 0; j < 16; ++j) { const f32x4 w = ((const LAS f32x4*)(wl + h * D))[F.lane + 64 * j];
                a0 += (bf_lo(w0[j].x) * w.x + bf_hi(w0[j].x) * w.y) + (bf_lo(w0[j].y) * w.z + bf_hi(w0[j].y) * w.w);
                a1 += (bf_lo(w1[j].x) * w.x + bf_hi(w1[j].x) * w.y) + (bf_lo(w1[j].y) * w.z + bf_hi(w1[j].y) * w.w); }
            a0 = wave_sum(a0); a1 = wave_sum(a1); mine0 = (F.lane == h) ? a0 : mine0; mine1 = (F.lane == h) ? a1 : mine1; }
        if (F.lane < 8) { const float z0 = mine0 * rstd0 + bff[F.lane]; lf[(size_t)row * 8 + F.lane] = fminf(z0, 0.f) - __logf(1.0f + __expf(-fabsf(z0)));
            const float z1 = mine1 * rstd1 + bff[F.lane]; lf[(size_t)row1 * 8 + F.lane] = fminf(z1, 0.f) - __logf(1.0f + __expf(-fabsf(z1))); }
    }
    __syncthreads();
}
__device__ __forceinline__ void final_rows(const Frame& F, const bf16* __restrict__ hb, const unsigned long long* __restrict__ ssq, const float* __restrict__ gain, float* __restrict__ out) {
    const int gw = F.vcu * NWAVES + F.wave, NGW = F.G * NWAVES;
    for (int row = gw; row < M; row += NGW) {
        const uint2* hr = (const uint2*)(hb + (size_t)row * D) + F.lane; f32x4* orow = (f32x4*)(out + (size_t)row * D) + F.lane; const f32x4* gr = (const f32x4*)gain + F.lane;
        const float rstd = 1.0f / sqrtf((float)ssq[row] * (1.0f / (1048576.0f * D)) + EPS);
#pragma unroll
        for (int j = 0; j < 16; ++j) { const uint2 w = hr[64 * j]; orow[64 * j] = (f32x4){bf_lo(w.x), bf_hi(w.x), bf_lo(w.y), bf_hi(w.y)} * rstd * gr[64 * j]; }
    }
}

__device__ __forceinline__ void p00_colmax(const Frame& F, const Args& P) {
    for (int fi = 0; fi < 4; ++fi) if ((I8_UP_MASK >> fi) & 1) { const int l = fi >> 1, wh = fi & 1;
        colmax_job(F, P.in[wh ? 19 : 2] + (size_t)l * D * NUP, NUP, D, NUP, P.in[wh ? 18 : 1] + (size_t)l * D, (unsigned*)(P.ws + WS_WMAX) + (size_t)fi * NUP); }
}
__device__ __forceinline__ void quant_rows(const Frame& F, const bf16* __restrict__ hb, unsigned char* __restrict__ hq, float* __restrict__ asc) {
    const int gw = F.vcu * NWAVES + F.wave, NGW = F.G * NWAVES;
    for (int row = gw; row < M; row += NGW) {
        const uint2* hr = (const uint2*)(hb + (size_t)row * D) + F.lane;
        f32x4 v[16]; float mx = 0.f;
#pragma unroll
        for (int j = 0; j < 16; ++j) { const uint2 w = hr[64 * j]; v[j] = (f32x4){bf_lo(w.x), bf_hi(w.x), bf_lo(w.y), bf_hi(w.y)};
            mx = fmaxf(fmaxf(mx, fmaxf(fabsf(v[j].x), fabsf(v[j].y))), fmaxf(fabsf(v[j].z), fabsf(v[j].w))); }
        mx = fmaxf(wave_max(mx), 1e-30f);
        const float inv = 127.0f / mx;
        unsigned char* qp = hq + ((size_t)(row >> 8) * (D / 128) * 256 + (row & 255)) * 128 + (size_t)(F.lane >> 5) * 32768 + ((4 * F.lane) & 127);
#pragma unroll
        for (int j = 0; j < 16; ++j) { unsigned w_ = 0u;
#pragma unroll
            for (int e = 0; e < 4; ++e) { int qv = __float2int_rn(v[j][e] * inv); qv = qv < -127 ? -127 : (qv > 127 ? 127 : qv); w_ |= ((unsigned)qv & 0xffu) << (8 * e); }
            *(unsigned*)(qp + (size_t)j * 65536) = w_; }
        if (F.lane == 0) asc[row] = mx * (1.0f / 127.0f);
    }
}

#ifndef W1_CLIP_SIGMAS
#define W1_CLIP_SIGMAS 4.0f
#endif
__device__ __forceinline__ void w1_colscale_all(const Frame& F, const Args& P) {
    const int gw = F.vcu * NWAVES + F.wave, NGW = F.G * NWAVES; constexpr int ncg = NUP / 256;
    for (int t = gw; t < 4 * ncg; t += NGW) { const int fi = t / ncg, cg = t - fi * ncg, l = fi >> 1, wh = fi & 1, c = cg * 256 + 4 * F.lane;
        const float* wp = P.in[wh ? 19 : 2] + (size_t)l * D * NUP + c; const float* ks = P.in[wh ? 18 : 1] + (size_t)l * D;
        f32x4 ss = {0.f, 0.f, 0.f, 0.f};
#pragma unroll 16
        for (int k = 0; k < D; k += 16) { const f32x4 v = *(const f32x4*)(wp + (size_t)k * NUP) * ks[k]; ss = ss + v * v; }
        const int half = c >= FF ? 1 : 0, cc = c - half * FF, dest = (cc >> 7) * 256 + half * 128 + (cc & 127);
        unsigned* cmax = (unsigned*)(P.ws + WS_WMAX) + (size_t)fi * NUP;
#pragma unroll
        for (int j = 0; j < 4; ++j) cmax[dest + j] = __float_as_uint(W1_CLIP_SIGMAS * sqrtf(ss[j] * (16.0f / D))); }
}
__device__ __forceinline__ void w1_colmax(const Frame& F, const Args& P, int fi) { const int l = fi >> 1, wh = fi & 1;
    colmax_job(F, P.in[wh ? 19 : 2] + (size_t)l * D * NUP, NUP, D, NUP, P.in[wh ? 18 : 1] + (size_t)l * D, (unsigned*)(P.ws + WS_WMAX) + (size_t)fi * NUP); }
__device__ __forceinline__ void w1_quant(const Frame& F, const Args& P, int fi) { const int l = fi >> 1, wh = fi & 1; unsigned char* ws = P.ws;
    transpose_job(F, P.in[wh ? 19 : 2] + (size_t)l * D * NUP, NUP, D, NUP, (bf16*)(ws + WS_W1T) + (size_t)fi * NUP * D, 0, P.in[wh ? 18 : 1] + (size_t)l * D, -1, 0, 0.f,
                  (const unsigned*)(ws + WS_WMAX) + (size_t)fi * NUP, 0, -1, 1, 1); }
__device__ __forceinline__ float sigmoidf_(float x) { return __builtin_amdgcn_rcpf(1.0f + __expf(-x)); }
__device__ __forceinline__ float gelu_tanh(float x) { const float z = 0.7978845608028654f * (x + 0.044715f * x * x * x); return x * __builtin_amdgcn_rcpf(1.0f + __expf(-2.0f * z)); }

__device__ __forceinline__ void lru_unit(const Frame& F, const Args& P, int l, int u) {
    typedef short bf16x8_t __attribute__((ext_vector_type(8)));
    const int g = u & 7, c = (u >> 3) & 31, b = u >> 8;
    const int t0 = c * 64; const size_t row0 = (size_t)b * SEQ + t0;
    const bf16* proj = (const bf16*)(P.ws + WS_PROJ);
    float* HL = (float*)(P.ws + WS_HL); float* PPp = (float*)(P.ws + WS_PP);
    const bf16* WG = (const bf16*)(P.ws + WS_WG);
    LAS float* xcf = (LAS float*)(F.lds + RING_OFF);
    LAS bf16* xcb = (LAS bf16*)(F.lds + RING_OFF + 32768);
    LAS bf16* xs = (LAS bf16*)(F.lds + RING_OFF + 50176);
    LAS float* Ul = (LAS float*)(F.lds + RING_OFF + 32768);
    LAS float* Al = (LAS float*)(F.lds + RING_OFF + 65536);
    const int w = F.wave, fr = F.lane & 15, fq = F.lane >> 4;
    bf16x8_t bfa[4], bfx[4];
    { const bf16* wa = WG + (((size_t)l * 2 + 0) * 8 + g) * 128 * 128 + (size_t)(16 * w + fr) * 128 + 8 * fq;
      const bf16* wx = WG + (((size_t)l * 2 + 1) * 8 + g) * 128 * 128 + (size_t)(16 * w + fr) * 128 + 8 * fq;
#pragma unroll
      for (int kk = 0; kk < 4; ++kk) { bfa[kk] = *(const bf16x8_t*)(wa + 32 * kk); bfx[kk] = *(const bf16x8_t*)(wx + 32 * kk); } }
    const int cc_ = 16 * w + fr, gc_ = g * 128 + cc_;
    const float ba_ = P.in[9][l * DL + gc_], bx_ = P.in[11][l * DL + gc_], lam_ = P.in[12][l * DL + gc_];
    for (int i = F.tid; i < 67 * 16; i += NWAVES * 64) { const int r = i >> 4, c8 = i & 15; const int t = t0 - 3 + r; v4u val = {0u, 0u, 0u, 0u};
        if (t >= 0) val = *(const v4u*)(proj + ((size_t)b * SEQ + t) * NIN + C_XA + g * 128 + c8 * 8);
        ((LAS v4u*)xs)[i] = val; }
    __syncthreads();
    const int ch = F.tid & 127, tq = F.tid >> 7, gch = g * 128 + ch;
    { const float* cw = P.in[6] + (size_t)l * 4 * DL; const float cb = P.in[7][l * DL + gch];
      const float w0 = cw[gch], w1 = cw[DL + gch], w2 = cw[2 * DL + gch], w3 = cw[3 * DL + gch];
#pragma unroll 4
      for (int tt = 0; tt < 16; ++tt) { const int t = tq * 16 + tt;
          const float v = cb + w0 * bf2f(xs[t * 128 + ch]) + w1 * bf2f(xs[(t + 1) * 128 + ch]) + w2 * bf2f(xs[(t + 2) * 128 + ch]) + w3 * bf2f(xs[(t + 3) * 128 + ch]);
          xcf[t * 128 + ch] = v; xcb[t * 136 + ch] = (bf16)(pg8::cvt_pk_bf16(v, v) & 0xffffu); } }
    __syncthreads();
    pg8::f32x4 accA[4], accX[4];
#pragma unroll
    for (int m = 0; m < 4; ++m) { accA[m] = (pg8::f32x4){0.f, 0.f, 0.f, 0.f}; accX[m] = accA[m]; }
#pragma unroll
    for (int kk = 0; kk < 4; ++kk) {
#pragma unroll
        for (int m = 0; m < 4; ++m) { const bf16x8_t af = *(const LAS bf16x8_t*)(xcb + (16 * m + fr) * 136 + 32 * kk + 8 * fq);
            accA[m] = __builtin_amdgcn_mfma_f32_16x16x32_bf16(af, bfa[kk], accA[m], 0, 0, 0); accX[m] = __builtin_amdgcn_mfma_f32_16x16x32_bf16(af, bfx[kk], accX[m], 0, 0, 0); } }
    __syncthreads();
    { const int cc = cc_; const float ba = ba_, bx = bx_;
      const float sp = __logf(1.0f + __expf(-lam_));
#pragma unroll
      for (int m = 0; m < 4; ++m)
#pragma unroll
          for (int j = 0; j < 4; ++j) { const int t = 16 * m + 4 * fq + j;
              const float r = sigmoidf_(accA[m][j] + ba), ig = sigmoidf_(accX[m][j] + bx);
              const float la = -8.0f * r * sp, a = __expf(la), mult = sqrtf(1.0f - a * a);
              Al[t * 128 + cc] = a; Ul[t * 128 + cc] = mult * (ig * xcf[t * 128 + cc]); } }
    __syncthreads();
    float hs[16], ps[16];
    { float h = 0.f, p = 1.f;
#pragma unroll
      for (int tt = 0; tt < 16; ++tt) { const int t = tq * 16 + tt; const float a = Al[t * 128 + ch], uu = Ul[t * 128 + ch]; h = a * h + uu; p *= a; hs[tt] = h; ps[tt] = p; }
      if (tq < 3) { Ul[(tq * 16 + 15) * 128 + ch] = h; Al[(tq * 16 + 15) * 128 + ch] = p; } }
    __syncthreads();
    { float cin = 0.f, pin = 1.f;
      for (int qq = 0; qq < tq; ++qq) { const float pa = Al[(qq * 16 + 15) * 128 + ch], hu = Ul[(qq * 16 + 15) * 128 + ch]; cin = pa * cin + hu; pin *= pa; }
#pragma unroll
      for (int tt = 0; tt < 16; ++tt) { const size_t o = (row0 + tq * 16 + tt) * DL + gch; HL[o] = hs[tt] + ps[tt] * cin; PPp[o] = ps[tt] * pin; } }
    __syncthreads();
}

__device__ __forceinline__ void attn_phase(const Frame& F, const Args& P, char* lds) {
    const bf16* proj = (const bf16*)(P.ws + WS_PROJ); const float* lf = (const float*)(P.ws + WS_LF);
    bf16* YB = (bf16*)(P.ws + WS_YB); bf16* YCP = (bf16*)(P.ws + WS_YCP); float* LSE = (float*)(P.ws + WS_LSE);
    for (int it = F.bx; it < BATCH * NFX * 4; it += F.G) {
        const int bh = it >> 2, x = it & 3, b = bh >> 3, h = bh & 7; const size_t rb = (size_t)b * SEQ;
        if (F.wave == 0) { LAS float* kbl = (LAS float*)(F.lds + RING_OFF + att::KB_OFF);
            const float* lp = lf + (rb + 32 * F.lane) * 8 + h; float loc[32]; float run = 0.f;
#pragma unroll
            for (int i = 0; i < 32; ++i) { run += lp[(size_t)i * 8]; loc[i] = run; }
            float inc = run;
#pragma unroll
            for (int o = 1; o < 64; o <<= 1) { const float t = __shfl_up(inc, o); if (F.lane >= o) inc += t; }
            const float excl = inc - run;
#pragma unroll
            for (int i = 0; i < 32; ++i) kbl[32 * F.lane + i] = -(excl + loc[i]) * (1.0f / att::SCALE); }
#pragma unroll 1
        for (int pass = 0; pass < 2; ++pass) { const int qb = pass ? x : 7 - x;
            att::Blk B;
            B.Q = proj + (rb + 256 * qb) * NIN + C_QF + h * 128; B.K = proj + rb * NIN + C_KF + h * 128; B.V = proj + rb * NIN + C_VF + h * 128;
            B.O = YB + (rb + 256 * qb) * DFX + h * 128; B.L = nullptr;
            B.qstride = NIN; B.kstride = NIN; B.ostride = DFX; B.lstride = 0; B.pair_off = 0; B.opair_off = 0; B.lpair_off = 0;
            B.P0 = 256 * qb; B.j_lo = 0; B.NT = 4 * (qb + 1); B.W = 1 << 20; B.pair = 0; B.kbias = nullptr;
            att::attn_block<true>(B, lds); }
    }
#pragma unroll 1
    for (int bi = F.bx; bi < BATCH * NDL * 24; bi += F.G) {
        const int bh = bi / 24, k = bi - bh * 24, b = bh >> 4, hh = bh & 15; const size_t rb = (size_t)b * SEQ;
        int pi, d, res, qb, pair;
        if (k < 8) { pi = 0; d = 1; res = 0; qb = k; pair = 0; }
        else if (k < 16) { pi = 1; d = 4; res = (k - 8) >> 1; qb = (k - 8) & 1; pair = 0; }
        else { pi = 2; d = 16; res = 2 * (k - 16); qb = 0; pair = 1; }
        const size_t r0 = rb + res + (size_t)(256 * qb) * d;
        att::Blk B;
        B.Q = proj + r0 * NIN + C_QD + hh * 128; B.K = proj + (rb + res) * NIN + C_KD + hh * 128; B.V = proj + (rb + res) * NIN + C_VD + hh * 128;
        B.O = YCP + (size_t)pi * M * DDL + r0 * DDL + hh * 128; B.L = LSE + (size_t)pi * M * NDL + r0 * NDL + hh;
        B.qstride = d * NIN; B.kstride = d * NIN; B.ostride = d * DDL; B.lstride = d * NDL; B.pair_off = NIN; B.opair_off = DDL; B.lpair_off = NDL;
        B.P0 = 256 * qb; B.W = 129; B.pair = pair; B.kbias = nullptr;
        if (pair) { B.j_lo = 0; B.NT = 4; }
        else { const int lowk = B.P0 - 129 + 1; B.j_lo = lowk > 0 ? lowk / 64 : 0; B.NT = (B.P0 + 255) / 64 + 1 - B.j_lo; }
        att::attn_block<false>(B, lds);
    }
}

__device__ __forceinline__ void merge_unit(const Frame& F, const Args& P, int l, int u) {
    const int c = u & 31, b = u >> 5; const size_t rb = (size_t)b * SEQ;
    const bf16* proj = (const bf16*)(P.ws + WS_PROJ); const float* HL = (const float*)(P.ws + WS_HL); const float* PPp = (const float*)(P.ws + WS_PP);
    const bf16* YB = (const bf16*)(P.ws + WS_YB); const bf16* YCP = (const bf16*)(P.ws + WS_YCP); const float* LSE = (const float*)(P.ws + WS_LSE); bf16* Y = (bf16*)(P.ws + WS_A1);
    LAS float* hin = (LAS float*)(F.lds + RING_OFF);
    for (int ch = F.tid; ch < DL; ch += NWAVES * 64) { float h = 0.f;
        for (int c0 = 0; c0 < c; c0 += 8) { float pa[8], ha[8];
#pragma unroll
            for (int k = 0; k < 8; ++k) { const int cc = (c0 + k < c) ? c0 + k : c - 1; const size_t r = (rb + 64 * cc + 63) * DL + ch; pa[k] = PPp[r]; ha[k] = HL[r]; }
#pragma unroll
            for (int k = 0; k < 8; ++k) if (c0 + k < c) h = pa[k] * h + ha[k]; }
        hin[ch] = h; }
    __syncthreads();
    const float* g_a = P.in[14] + (size_t)l * DL; const float* g_b = P.in[15] + (size_t)l * DFX; const float* g_c = P.in[16] + (size_t)l * DDL;
    const int lane = F.lane;
    for (int rr = F.wave; rr < 64; rr += NWAVES) { const size_t row = rb + 64 * c + rr;
        f32x4 hl[4], pp[4]; uint2 gw[4], yb[4], a0[8], a1[8], a2[8]; float l0[8], l1[8], l2[8];
#pragma unroll
        for (int j = 0; j < 4; ++j) { const int chb = 4 * lane + 256 * j;
            hl[j] = *(const f32x4*)(HL + row * DL + chb); pp[j] = *(const f32x4*)(PPp + row * DL + chb); gw[j] = *(const uint2*)(proj + row * NIN + C_GA + chb);
            yb[j] = *(const uint2*)(YB + row * DFX + chb); }
#pragma unroll
        for (int j = 0; j < 8; ++j) { const int chb = 4 * lane + 256 * j, head = 2 * j + (lane >> 5);
            l0[j] = LSE[row * NDL + head]; l1[j] = LSE[(size_t)M * NDL + row * NDL + head]; l2[j] = LSE[(size_t)2 * M * NDL + row * NDL + head];
            a0[j] = *(const uint2*)(YCP + row * DDL + chb); a1[j] = *(const uint2*)(YCP + (size_t)M * DDL + row * DDL + chb); a2[j] = *(const uint2*)(YCP + (size_t)2 * M * DDL + row * DDL + chb); }
        { f32x4 y[4]; float ss = 0.f;
#pragma unroll
          for (int j = 0; j < 4; ++j) { const int chb = 4 * lane + 256 * j;
              const f32x4 hi = *(const LAS f32x4*)(hin + chb);
              f32x4 hv = hl[j] + pp[j] * hi;
              y[j] = (f32x4){hv.x * gelu_tanh(bf_lo(gw[j].x)), hv.y * gelu_tanh(bf_hi(gw[j].x)), hv.z * gelu_tanh(bf_lo(gw[j].y)), hv.w * gelu_tanh(bf_hi(gw[j].y))};
              ss += (y[j].x * y[j].x + y[j].y * y[j].y) + (y[j].z * y[j].z + y[j].w * y[j].w); }
          const float rstd = 1.0f / sqrtf(wave_sum(ss) * (1.0f / DL) + EPS);
#pragma unroll
          for (int j = 0; j < 4; ++j) { const int chb = 4 * lane + 256 * j; const f32x4 o = y[j] * rstd * *(const f32x4*)(g_a + chb);
              *(unsigned long long*)(Y + row * D + chb) = (unsigned long long)pg8::cvt_pk_bf16(o.x, o.y) | ((unsigned long long)pg8::cvt_pk_bf16(o.z, o.w) << 32); } }
        { f32x4 y[4]; float ss = 0.f;
#pragma unroll
          for (int j = 0; j < 4; ++j) { const uint2 w = yb[j];
              y[j] = (f32x4){bf_lo(w.x), bf_hi(w.x), bf_lo(w.y), bf_hi(w.y)};
              ss += (y[j].x * y[j].x + y[j].y * y[j].y) + (y[j].z * y[j].z + y[j].w * y[j].w); }
          const float rstd = 1.0f / sqrtf(wave_sum(ss) * (1.0f / DFX) + EPS);
#pragma unroll
          for (int j = 0; j < 4; ++j) { const int chb = 4 * lane + 256 * j; const f32x4 o = y[j] * rstd * *(const f32x4*)(g_b + chb);
              *(unsigned long long*)(Y + row * D + DL + chb) = (unsigned long long)pg8::cvt_pk_bf16(o.x, o.y) | ((unsigned long long)pg8::cvt_pk_bf16(o.z, o.w) << 32); } }
        { f32x4 y[8]; float ss = 0.f;
#pragma unroll
          for (int j = 0; j < 8; ++j) {
              const float lm = fmaxf(l0[j], fmaxf(l1[j], l2[j])); float w0 = __expf(l0[j] - lm), w1 = __expf(l1[j] - lm), w2 = __expf(l2[j] - lm); const float wi = 1.0f / (w0 + w1 + w2); w0 *= wi; w1 *= wi; w2 *= wi;
              y[j] = (f32x4){w0 * bf_lo(a0[j].x) + w1 * bf_lo(a1[j].x) + w2 * bf_lo(a2[j].x), w0 * bf_hi(a0[j].x) + w1 * bf_hi(a1[j].x) + w2 * bf_hi(a2[j].x),
                             w0 * bf_lo(a0[j].y) + w1 * bf_lo(a1[j].y) + w2 * bf_lo(a2[j].y), w0 * bf_hi(a0[j].y) + w1 * bf_hi(a1[j].y) + w2 * bf_hi(a2[j].y)};
              ss += (y[j].x * y[j].x + y[j].y * y[j].y) + (y[j].z * y[j].z + y[j].w * y[j].w); }
          const float rstd = 1.0f / sqrtf(wave_sum(ss) * (1.0f / DDL) + EPS);
#pragma unroll
          for (int j = 0; j < 8; ++j) { const int chb = 4 * lane + 256 * j; const f32x4 o = y[j] * rstd * *(const f32x4*)(g_c + chb);
              *(unsigned long long*)(Y + row * D + DL + DFX + chb) = (unsigned long long)pg8::cvt_pk_bf16(o.x, o.y) | ((unsigned long long)pg8::cvt_pk_bf16(o.z, o.w) << 32); } }
    }
    __syncthreads();
}
#ifndef TAIL_SPLIT_PCT
#define TAIL_SPLIT_PCT 75
#endif
#ifndef WGM_OUT
#define WGM_OUT 8
#endif
#ifndef WGM_IN
#define WGM_IN 8
#endif
#ifndef WGM_UP
#define WGM_UP 8
#endif
#ifndef WGM_DOWN
#define WGM_DOWN 2
#endif
#ifndef PG8_ALIGN_UP
#define PG8_ALIGN_UP true
#endif
#ifndef PG8_SP2
#define PG8_SP2 true
#endif
#ifndef PG8_ALIGN
#define PG8_ALIGN true
#endif
__global__ void __launch_bounds__(NWAVES * 64, 2) hymba_fwd(Args args) {
    extern __shared__ __attribute__((aligned(16))) unsigned char lds[];
    Frame F;
#define FRESH_F() do { int tz_ = threadIdx.x; asm volatile("" : "+v"(tz_)); int g_ = gridDim.x, bx_ = blockIdx.x; asm volatile("" : "+s"(g_), "+s"(bx_)); \
        F.lds = (LAS unsigned char*)lds; F.tid = tz_; F.lane = tz_ & 63; F.wave = __builtin_amdgcn_readfirstlane(tz_ >> 6); F.G = g_; F.bx = bx_; \
        F.vcu = (g_ % 8 == 0) ? (bx_ % 8) * (g_ / 8) + bx_ / 8 : bx_; } while (0)
    FRESH_F();
    const Args& P = args;
    unsigned char* ws = args.ws;
    gu32* ctl = (gu32*)(ws + WS_CTL);
    volatile LAS unsigned* MISC = (volatile LAS unsigned*)(F.lds + MISC_OFF);
    for (int u = F.tid; u < (LDS_BYTES - LDSCTL_OFF) / 4; u += NWAVES * 64) ((LAS unsigned*)(F.lds + LDSCTL_OFF))[u] = 0u;
    __syncthreads();
    XcdBarrier bar = xcd_barrier_post((unsigned*)(ctl + CW_BAR) + args.li * XCD_BAR_WORDS, MISC + 8);
    const int lo = args.ph_lo, hi = args.ph_hi;
    int pc = 0;
#define PH_ON() (pc >= lo && pc < hi)
#ifndef EN_MASK
#define EN_MASK 0x3ff
#endif
#define EN(k) (((EN_MASK) >> (k)) & 1)
#ifndef REP_MASK
#define REP_MASK 0
#endif
#define REP(k) (1 + (((REP_MASK) >> (k)) & 1))
#ifdef PROBE_PC
    unsigned long long pr_prev_ = __builtin_amdgcn_s_memrealtime(), pr_acc_ = 0, pc_prev_ = __builtin_amdgcn_s_memtime(), pc_acc_ = 0;
#ifdef PROBE_INCL_BAR
#define PH_END() do { if (PH_ON() && pc + 1 < hi) xcd_barrier(bar); { const unsigned long long nowc_ = __builtin_amdgcn_s_memtime(), now_ = __builtin_amdgcn_s_memrealtime(); if (PROBE_PC(pc)) { pr_acc_ += now_ - pr_prev_; pc_acc_ += nowc_ - pc_prev_; } } \
        pr_prev_ = __builtin_amdgcn_s_memrealtime(); pc_prev_ = __builtin_amdgcn_s_memtime(); ++pc; } while (0)
#else
#define PH_END() do { { const unsigned long long nowc_ = __builtin_amdgcn_s_memtime(), now_ = __builtin_amdgcn_s_memrealtime(); if (PROBE_PC(pc)) { pr_acc_ += now_ - pr_prev_; pc_acc_ += nowc_ - pc_prev_; } } \
        if (PH_ON() && pc + 1 < hi) xcd_barrier(bar); pr_prev_ = __builtin_amdgcn_s_memrealtime(); pc_prev_ = __builtin_amdgcn_s_memtime(); ++pc; } while (0)
#endif
#else
#define PH_END() do { if (PH_ON() && pc + 1 < hi) xcd_barrier(bar); ++pc; } while (0)
#endif

    bf16* W1T = (bf16*)(ws + WS_W1T); bf16* W2T = (bf16*)(ws + WS_W2T); bf16* WIN = (bf16*)(ws + WS_WIN); bf16* WOUT = (bf16*)(ws + WS_WOUT);
    bf16* A1 = (bf16*)(ws + WS_A1); bf16* HB = (bf16*)(ws + WS_HB); unsigned char* HB8 = ws + WS_HB8; float* ASC = (float*)(ws + WS_ASC); unsigned long long* SSQ = (unsigned long long*)(ws + WS_SSQ); bf16* ACT = (bf16*)(ws + WS_ACT); bf16* PROJ = (bf16*)(ws + WS_PROJ);
    const float* rope_c = (const float*)(ws + WS_ROPE); const float* rope_s = rope_c + SEQ * 16;
    float* LFp = (float*)(ws + WS_LF);

    static_assert(I8_UP_MASK == 0xF, "this phase program makes an int8 copy of every FFN's up weights");
    if (PH_ON() && EN(0)) { FRESH_F(); w1_colscale_all(F, P); }
    PH_END();
    if (PH_ON() && EN(0)) {
#pragma unroll 1
        for (int fq_ = 0; fq_ < 4; ++fq_) { FRESH_F(); w1_quant(F, P, fq_); }
        FRESH_F(); p0_prologue(F, P); }
    PH_END();

#pragma unroll
    for (int fi = 0; fi < 4; ++fi) {
        const int l = fi >> 1, wh = fi & 1;
        if (PH_ON() && EN(1)) { FRESH_F(); if (fi > 0 && ((I8_UP_MASK >> fi) & 1)) quant_rows(F, HB, HB8, ASC); }
        PH_END();
        if (PH_ON() && EN(2)) for (int rep_ = 0; rep_ < REP(2); ++rep_) { if (rep_) xcd_barrier(bar); FRESH_F(); pg8::StaticOrder S; S.init(M, NUP, F.G, (int)F.bx, WGM_UP);
            static_assert((FP8_DOWN_MASK & ~(FP8_UP_MASK | I8_UP_MASK)) == 0 && (FP8_UP_MASK & I8_UP_MASK) == 0, "an fp8 down GEMM takes its A operand from an fp8 or int8 up GEMM's epilogue in this build");
            if (I8_UP_MASK == 0xF || ((I8_UP_MASK >> fi) & 1)) { pg8::Gemm g{(const bf16*)HB8, W1T + (size_t)fi * NUP * D, M, NUP, D / 2};
                const float* wmx = (const float*)(ws + WS_WMAX) + (size_t)fi * NUP;
                if ((FP8_DOWN_MASK >> fi) & 1) { pg8::EpiSwiglu<true, true> E{ACT, FF / 128, SSQ + (size_t)(3 * l + 2 * wh) * M, 1.0f / (1048576.0f * D), EPS, 1.0f, FP8_ACT_MUL, ASC, wmx};
                    pg8::gemm_phase<pg8::EpiSwiglu<true, true>, pg8::StaticOrder, PG8_ALIGN_UP, PG8_SP2, false, true, true>(F.lds + RING_OFF, g, S, E); }
                else { pg8::EpiSwiglu<false, true> E{ACT, FF / 64, SSQ + (size_t)(3 * l + 2 * wh) * M, 1.0f / (1048576.0f * D), EPS, 1.0f, 1.0f, ASC, wmx};
                    pg8::gemm_phase<pg8::EpiSwiglu<false, true>, pg8::StaticOrder, PG8_ALIGN_UP, PG8_SP2, false, true, true>(F.lds + RING_OFF, g, S, E); } }
            else if ((FP8_UP_MASK >> fi) & 1) { pg8::Gemm g{(const bf16*)HB8, W1T + (size_t)fi * NUP * D, M, NUP, D / 2};
                if ((FP8_DOWN_MASK >> fi) & 1) { pg8::EpiSwiglu<true> E{ACT, FF / 128, SSQ + (size_t)(3 * l + 2 * wh) * M, 1.0f / (1048576.0f * D), EPS, 1.0f / FP8_WMUL, FP8_ACT_MUL, nullptr, nullptr};
                    pg8::gemm_phase<pg8::EpiSwiglu<true>, pg8::StaticOrder, PG8_ALIGN_UP, PG8_SP2, true>(F.lds + RING_OFF, g, S, E); }
                else { pg8::EpiSwiglu<false> E{ACT, FF / 64, SSQ + (size_t)(3 * l + 2 * wh) * M, 1.0f / (1048576.0f * D), EPS, 1.0f / FP8_WMUL, 1.0f, nullptr, nullptr};
                    pg8::gemm_phase<pg8::EpiSwiglu<false>, pg8::StaticOrder, PG8_ALIGN_UP, PG8_SP2, true>(F.lds + RING_OFF, g, S, E); } }
            else { pg8::Gemm g{HB, W1T + (size_t)fi * NUP * D, M, NUP, D};
                pg8::EpiSwiglu<false> E{ACT, FF / 64, SSQ + (size_t)(3 * l + 2 * wh) * M, 1.0f / (1048576.0f * D), EPS, 1.0f, 1.0f, nullptr, nullptr};
                pg8::gemm_phase<pg8::EpiSwiglu<false>, pg8::StaticOrder, PG8_ALIGN_UP, PG8_SP2>(F.lds + RING_OFF, g, S, E); }
            { const int nwg_ = (M / 256) * (NUP / 256), full_ = nwg_ / F.G, extra_ = nwg_ - full_ * F.G;
              const float* Wsrc = P.in[wh ? 20 : 3] + (size_t)l * FF * D; bf16* Wdst = W2T + (size_t)fi * D * FF;
              const float f8m_ = ((FP8_DOWN_MASK >> fi) & 1) ? FP8_WMUL_DOWN : 0.f;
              if (extra_ > 0 && extra_ < F.G) { const int nit_ = (FF / 64) * (D / 64), split_ = (nit_ * TAIL_SPLIT_PCT) / 100;
                  if (F.bx >= extra_) transpose_job(F, Wsrc, D, FF, D, Wdst, 1, nullptr, (F.bx - extra_) * NWAVES + F.wave, (F.G - extra_) * NWAVES, f8m_, nullptr, 0, split_, 1);
                  else transpose_job(F, Wsrc, D, FF, D, Wdst, 1, nullptr, F.bx * NWAVES + F.wave, extra_ * NWAVES, f8m_, nullptr, split_, nit_, 1); }
              else transpose_job(F, Wsrc, D, FF, D, Wdst, 1, nullptr, -1, 0, f8m_, nullptr, 0, -1, 1); }
            }
        PH_END();
        if (PH_ON() && EN(3)) { FRESH_F(); pg8::StaticOrder S; S.init(M, D, F.G, (int)F.bx, WGM_DOWN);
            if ((FP8_DOWN_MASK >> fi) & 1) { pg8::Gemm g{ACT, W2T + (size_t)fi * D * FF, M, D, FF / 2};
                pg8::EpiResidB E{HB, D, 0.5f / (FP8_WMUL_DOWN * FP8_ACT_MUL), SSQ + (size_t)(3 * l + 2 * wh + 1) * M, HB8};
                pg8::gemm_phase<pg8::EpiResidB, pg8::StaticOrder, PG8_ALIGN, PG8_SP2, true, false, true>(F.lds + RING_OFF, g, S, E); }
            else { pg8::Gemm g{ACT, W2T + (size_t)fi * D * FF, M, D, FF};
                pg8::EpiResidB E{HB, D, 0.5f, SSQ + (size_t)(3 * l + 2 * wh + 1) * M, HB8};
                pg8::gemm_phase<pg8::EpiResidB, pg8::StaticOrder, PG8_ALIGN, PG8_SP2, false, false, true>(F.lds + RING_OFF, g, S, E); } }
        PH_END();
        if (wh == 0) {
            if (PH_ON() && EN(5)) for (int rep_ = 0; rep_ < REP(5); ++rep_) { if (rep_) xcd_barrier(bar); FRESH_F();
                ff_rows(F, HB, SSQ + (size_t)(3 * l + 1) * M, (const float*)(ws + WS_WFF) + (size_t)l * 8 * D, P.in[13] + l * 8, LFp);
                pg8::Gemm g{HB, WIN + (size_t)l * NIN * D, M, NIN, D}; pg8::StaticOrder S; S.init(M, NIN, F.G, (int)F.bx, WGM_IN);
                pg8::EpiProj E{PROJ, NIN, rope_c, rope_s, C_QD / 256, C_VD / 256, SSQ + (size_t)(3 * l + 1) * M, 1.0f / (1048576.0f * D), EPS};
                pg8::gemm_phase<pg8::EpiProj, pg8::StaticOrder, PG8_ALIGN, PG8_SP2>(F.lds + RING_OFF, g, S, E); }
            PH_END();
            if (PH_ON() && EN(6)) for (int rep_ = 0; rep_ < REP(6); ++rep_) { if (rep_) xcd_barrier(bar); FRESH_F();
                for (int u = F.bx; u < BATCH * 32 * 8; u += F.G) lru_unit(F, P, l, u);
                attn_phase(F, P, (char*)lds);
            }
            PH_END();
            if (PH_ON() && EN(7)) for (int rep_ = 0; rep_ < REP(7); ++rep_) { if (rep_) xcd_barrier(bar); FRESH_F(); for (int u = F.bx; u < BATCH * 32; u += F.G) merge_unit(F, P, l, u); }
            PH_END();
            if (PH_ON() && EN(8)) { FRESH_F(); pg8::Gemm g{A1, WOUT + (size_t)l * D * D, M, D, D}; pg8::StaticOrder S; S.init(M, D, F.G, (int)F.bx, WGM_OUT);
                pg8::EpiResidB E{HB, D, 1.0f, SSQ + (size_t)(3 * l + 2) * M, HB8};
                pg8::gemm_phase<pg8::EpiResidB, pg8::StaticOrder, PG8_ALIGN, PG8_SP2>(F.lds + RING_OFF, g, S, E); }
            PH_END();
        }
    }
#ifdef PROBE_BAR
    for (int i_ = 0; i_ < PROBE_BAR; ++i_) xcd_barrier(bar);
#endif
    if (PH_ON() && EN(9)) { FRESH_F(); final_rows(F, HB, SSQ + (size_t)6 * M, P.in[21], P.out); }
    PH_END();
#ifdef PROBE_PC
#ifdef PROBE_AS_CLK
    pr_acc_ = (pc_acc_ * 100ull / (pr_acc_ ? pr_acc_ : 1ull)) * 100ull;
#endif
    if (blockIdx.x == 0 && threadIdx.x == 0) { const unsigned long long t0 = __builtin_amdgcn_s_memrealtime(); while (__builtin_amdgcn_s_memrealtime() - t0 < pr_acc_) __builtin_amdgcn_s_sleep(32); }
#endif
#undef PH_ON
#undef PH_END
}

constexpr int N_PHASES = 2 + 4 * 3 + 2 * 4 + 1;
extern "C" void kernel_launch(void* const* d_in, const int* in_sizes, int n_in, void* d_out, int out_size, void* d_ws, size_t ws_size, hipStream_t stream) {
    static int grid = 0;
    if (grid == 0) {
        if (n_in != 22 || in_sizes[0] != M * D || out_size != M * D || ws_size < WS_END) {
            fprintf(stderr, "kernel_launch: shape/workspace mismatch: n_in %d in0 %d out %d ws %zu (need %zu); nothing launched\n", n_in, n_in > 0 ? in_sizes[0] : -1, out_size, ws_size, (size_t)WS_END); grid = -1; return; }
        int dev = 0, cus = 0, per_cu = 0;
        if (hipGetDevice(&dev) != hipSuccess || hipDeviceGetAttribute(&cus, hipDeviceAttributeMultiprocessorCount, dev) != hipSuccess) { grid = -1; return; }
        if (hipFuncSetAttribute((const void*)hymba_fwd, hipFuncAttributeMaxDynamicSharedMemorySize, LDS_BYTES) != hipSuccess) { fprintf(stderr, "kernel_launch: hipFuncSetAttribute failed\n"); grid = -1; return; }
        if (hipOccupancyMaxActiveBlocksPerMultiprocessor(&per_cu, (const void*)hymba_fwd, NWAVES * 64, LDS_BYTES) != hipSuccess || per_cu < 1) {
            fprintf(stderr, "kernel_launch: occupancy query reports %d workgroups per CU\n", per_cu); }
        (void)hipGetLastError();
        grid = cus;
    }
    if (grid < 0) return;
    if (hipMemsetAsync((char*)d_ws + WS_CTL, 0, CTL_ZERO_BYTES, stream) != hipSuccess) return;
    Args a{};
    for (int i = 0; i < 22; ++i) a.in[i] = (const float*)d_in[i];
    a.out = (float*)d_out; a.ws = (unsigned char*)d_ws;
#ifndef MK_CUTS
    a.ph_lo = 0; a.ph_hi = N_PHASES; a.li = 0; a.pad = 0;
    hipLaunchKernelGGL(hymba_fwd, dim3(grid), dim3(NWAVES * 64), LDS_BYTES, stream, a);
#else
    { const int cuts[] = {MK_CUTS, N_PHASES}; int lo = 0;
      for (int li = 0; li < (int)(sizeof(cuts) / sizeof(int)); ++li) { a.ph_lo = lo; a.ph_hi = cuts[li]; a.li = li; a.pad = 0; lo = cuts[li];
          hipLaunchKernelGGL(hymba_fwd, dim3(grid), dim3(NWAVES * 64), LDS_BYTES, stream, a); } }
#endif
}
```
